# Optimizing an MI355X kernel written in HIP

```python
import math
import jax, jax.numpy as jnp
from jax import lax
import numpy as np

D_MODEL = 1024
BATCH = 4
SEQ = 8192
DEPTH = 2

HEAD_DIM = 64
N_SLOTS = 8
DILATED_GROUPS = ((128, 1), (512, 4), (2048, 16))
N_GROUPS = len(DILATED_GROUPS)
HALF_SPAN = 64
BLK = 64
ATT_WIDTH = N_SLOTS * HEAD_DIM
QKV_WIDTH = N_GROUPS * 3 * ATT_WIDTH
ALIBI_MAX = 8.0
POOL_WINDOWS = (2, 4, 8, 16)
POOL_GROUP = 128
POOL_WIDTH = len(POOL_WINDOWS) * POOL_GROUP
IN_WIDTH = QKV_WIDTH + POOL_WIDTH + 2 * D_MODEL
D_FF = -(-8 * D_MODEL // (3 * 256)) * 256
ALPHA = (2 * DEPTH) ** 0.25
BETA = (8 * DEPTH) ** -0.25
LN_EPS = 1e-5
N_MOD = 6

kernel_name = "hybrid_dilated_attn_pool_deepnorm_adaln"


def layer_norm(x, g=None, b=None):
    xf = x.astype(jnp.float32)
    mu = jnp.mean(xf, axis=-1, keepdims=True)
    var = jnp.mean(jnp.square(xf - mu), axis=-1, keepdims=True)
    y = (xf - mu) * lax.rsqrt(var + LN_EPS)
    if g is not None:
        y = y * g.astype(jnp.float32) + b.astype(jnp.float32)
    return y.astype(x.dtype)


def alibi_slopes():
    n = N_GROUPS * N_SLOTS
    i = jnp.arange(1, n + 1, dtype=jnp.float32)
    return jnp.exp2(-ALIBI_MAX * i / n).reshape(N_GROUPS, N_SLOTS)


def dilated_band_attention(q, k, v, rate, slopes):
    B, S, H, Dh = q.shape
    L = S // rate
    nb = -(-L // BLK)
    Lp = nb * BLK

    def phases(t):
        t = t.reshape(B, L, rate, H, Dh).transpose(0, 2, 3, 1, 4).reshape(B * rate, H, L, Dh)
        return jnp.pad(t, ((0, 0), (0, 0), (0, Lp - L), (0, 0)))

    def windows(t):
        t = jnp.pad(t, ((0, 0), (0, 0), (BLK, BLK), (0, 0))).reshape(B * rate, H, nb + 2, BLK, Dh)
        return jnp.concatenate([t[:, :, :-2], t[:, :, 1:-1], t[:, :, 2:]], axis=3)

    qb = phases(q).reshape(B * rate, H, nb, BLK, Dh)
    kw = windows(phases(k))
    vw = windows(phases(v))

    scores = jnp.einsum('bhnqd,bhnkd->bhnqk', qb, kw).astype(jnp.float32) * (Dh ** -0.5)
    a = jnp.arange(BLK)[:, None]
    cidx = jnp.arange(3 * BLK)[None, :]
    rel = cidx - BLK - a
    kpos = (jnp.arange(nb)[:, None] - 1) * BLK + jnp.arange(3 * BLK)[None, :]
    valid = (jnp.abs(rel) <= HALF_SPAN)[None] & ((kpos >= 0) & (kpos < L))[:, None, :]
    dist = (rate * jnp.abs(rel)).astype(jnp.float32)
    scores = scores - slopes.astype(jnp.float32)[:, None, None, None] * dist[None, None]
    scores = jnp.where(valid, scores, -1e30)
    lse = jax.nn.logsumexp(scores, axis=-1)
    p = jnp.exp(scores - lse[..., None])
    out = jnp.einsum('bhnqk,bhnkd->bhnqd', p.astype(vw.dtype), vw)

    out = out.reshape(B * rate, H, Lp, Dh)[:, :, :L]
    out = out.reshape(B, rate, H, L, Dh).transpose(0, 3, 1, 2, 4).reshape(B, S, H, Dh)
    lse = lse.reshape(B * rate, H, Lp)[:, :, :L]
    lse = lse.reshape(B, rate, H, L).transpose(0, 3, 1, 2).reshape(B, S, H)
    return out, lse


def centred_pool_minus_identity(u, window):
    B, S, C = u.shape
    cs = jnp.concatenate([jnp.zeros((B, 1, C), jnp.float32),
                          jnp.cumsum(u.astype(jnp.float32), axis=1)], axis=1)
    t = jnp.arange(S)
    lo = jnp.clip(t - window // 2, 0, S)
    hi = jnp.clip(t + window // 2, 0, S)
    mean = (cs[:, hi] - cs[:, lo]) / (hi - lo).astype(jnp.float32)[None, :, None]
    return (mean - u.astype(jnp.float32)).astype(u.dtype)


def setup_inputs(seed: int = 0) -> dict:
    key = jax.random.key(seed)
    ks = jax.random.split(key, 20)
    f32 = jnp.float32
    nrm = lambda k, shape, s: jax.random.normal(k, shape, f32) * s
    L = DEPTH
    return {
        "x": nrm(ks[0], (BATCH, SEQ, D_MODEL), 1.0),
        "c": nrm(ks[1], (BATCH, D_MODEL), 1.0),
        "w_ada": nrm(ks[2], (L, D_MODEL, N_MOD * D_MODEL), 0.2 * D_MODEL ** -0.5),
        "b_ada": nrm(ks[3], (L, N_MOD * D_MODEL), 0.01),
        "w_in": nrm(ks[4], (L, D_MODEL, IN_WIDTH), D_MODEL ** -0.5),
        "w_pool_mix": nrm(ks[5], (L, len(POOL_WINDOWS), POOL_GROUP, POOL_GROUP), POOL_GROUP ** -0.5),
        "pool_scale": 1.0 + nrm(ks[6], (L, POOL_WIDTH), 0.1),
        "w_att_out": nrm(ks[7], (L, ATT_WIDTH, D_MODEL), ATT_WIDTH ** -0.5),
        "w_pool_out": nrm(ks[8], (L, POOL_WIDTH, D_MODEL), POOL_WIDTH ** -0.5),
        "w_o": nrm(ks[9], (L, D_MODEL, D_MODEL), BETA * D_MODEL ** -0.5),
        "ln1_g": 1.0 + nrm(ks[10], (L, D_MODEL), 0.05),
        "ln1_b": nrm(ks[11], (L, D_MODEL), 0.02),
        "w_ffn_in": nrm(ks[12], (L, D_MODEL, 2 * D_FF), D_MODEL ** -0.5),
        "w_ffn_out": nrm(ks[13], (L, D_FF, D_MODEL), BETA * D_FF ** -0.5),
        "ln2_g": 1.0 + nrm(ks[14], (L, D_MODEL), 0.05),
        "ln2_b": nrm(ks[15], (L, D_MODEL), 0.02),
    }


def reference(x, c, w_ada, b_ada, w_in, w_pool_mix, pool_scale, w_att_out, w_pool_out, w_o,
              ln1_g, ln1_b, w_ffn_in, w_ffn_out, ln2_g, ln2_b):
    B, S, D = x.shape
    slopes = alibi_slopes()
    for l in range(DEPTH):
        mod = jax.nn.silu(c) @ w_ada[l] + b_ada[l]
        shift1, scale1, gate1, shift2, scale2, gate2 = [m[:, None, :] for m in jnp.split(mod, N_MOD, axis=-1)]

        h = layer_norm(x) * (1.0 + scale1) + shift1
        proj = h @ w_in[l]
        qkv = proj[..., :QKV_WIDTH].reshape(B, S, N_GROUPS, 3, N_SLOTS, HEAD_DIM)
        pool_in = proj[..., QKV_WIDTH:QKV_WIDTH + POOL_WIDTH]
        gate_att = proj[..., QKV_WIDTH + POOL_WIDTH:QKV_WIDTH + POOL_WIDTH + D]
        gate_pool = proj[..., QKV_WIDTH + POOL_WIDTH + D:]

        outs, lses = [], []
        for g, (_, rate) in enumerate(DILATED_GROUPS):
            o, s = dilated_band_attention(qkv[:, :, g, 0], qkv[:, :, g, 1], qkv[:, :, g, 2], rate, slopes[g])
            outs.append(o)
            lses.append(s)
        wts = jax.nn.softmax(jnp.stack(lses, axis=0), axis=0)
        att = jnp.sum(wts[..., None].astype(x.dtype) * jnp.stack(outs, axis=0), axis=0)
        y_att = att.reshape(B, S, ATT_WIDTH) @ w_att_out[l]

        pu = pool_in.reshape(B, S, len(POOL_WINDOWS), POOL_GROUP)
        pooled = jnp.stack([centred_pool_minus_identity(pu[:, :, i], w) for i, w in enumerate(POOL_WINDOWS)], axis=2)
        pooled = jnp.einsum('bsgc,gcd->bsgd', pooled, w_pool_mix[l]).reshape(B, S, POOL_WIDTH) * pool_scale[l]
        y_pool = pooled @ w_pool_out[l]

        merged = jax.nn.sigmoid(gate_att) * y_att + jax.nn.sigmoid(gate_pool) * y_pool
        mix_out = merged @ w_o[l]
        x = layer_norm(ALPHA * x + (1.0 + gate1) * mix_out, ln1_g[l], ln1_b[l])

        h2 = layer_norm(x) * (1.0 + scale2) + shift2
        a_, b_ = jnp.split(h2 @ w_ffn_in[l], 2, axis=-1)
        ffn_out = (jax.nn.silu(a_) * b_) @ w_ffn_out[l]
        x = layer_norm(ALPHA * x + (1.0 + gate2) * ffn_out, ln2_g[l], ln2_b[l])
    return x
```

```cpp
#define DBG_STAGE 0
#include <hip/hip_runtime.h>
#include <hip/hip_cooperative_groups.h>
#include <cstdio>
#include <cstdint>
namespace cg = cooperative_groups;

namespace pg8 {
#define PG8_LAS __attribute__((address_space(3)))
typedef unsigned short bf16_t;
typedef short bf16x8 __attribute__((ext_vector_type(8)));
typedef float f32x4 __attribute__((ext_vector_type(4)));
typedef unsigned u32x4 __attribute__((ext_vector_type(4)));
constexpr int BM = 256, BK = 64, HALF = 128, HTB = HALF * BK * 2  , STAGE_BYTES = 8 * HTB, NXCD = 8, WGM = 8;

__host__ __device__ __forceinline__ int lds_byte(int r, int c) { const int st = (r >> 4) * 2 + (c >> 5), rr = r & 15, cc = c & 31, ob = rr * 64 + cc * 2; return st * 1024 + (ob ^ (((ob >> 9) & 1) << 5)); }
__host__ __device__ __forceinline__ void stage_rc(int b, int& R, int& C) { const int st = b / 1024, sb = b % 1024, swz = sb ^ (((sb >> 9) & 1) << 5); R = (st >> 1) * 16 + swz / 64; C = (st & 1) * 32 + (swz % 64) / 2; }
__host__ __device__ __forceinline__ int perm32(int rho) { const int n = rho >> 4, i = rho & 15; return 8 * (i >> 2) + 4 * n + (i & 3); }

struct Unit { int pm, pn; };
struct Gemm { const bf16_t* A; const bf16_t* Bt; int M, N, K; int bshift; };

struct StaticOrder {
    int nM, nN, nwg, G, c;
    __host__ __device__ void init(int M, int N, int G_, int c_) { nM = M / BM; nN = N / BM; nwg = nM * nN; G = G_; c = c_; }
    __host__ __device__ bool next(int i, Unit& u) const {
        const long L = (long)i * G + c; if (L >= nwg) return false;
        int wgid = (int)L; { const int q = nwg / NXCD, r = nwg % NXCD, xcd = wgid % NXCD, off = wgid / NXCD; wgid = (xcd < r ? xcd * (q + 1) : r * (q + 1) + (xcd - r) * q) + off; }
        const int nig = WGM * nN, gid = wgid / nig, fm = gid * WGM, gsz = (nM - fm) < WGM ? (nM - fm) : WGM;
        u.pm = fm + ((wgid % nig) % gsz); u.pn = (wgid % nig) / gsz; return true;
    }
    __device__ __forceinline__ void a_ready(const Unit&) const {}
    __device__ __forceinline__ void done(const Unit&) const {}
};

__device__ __forceinline__ unsigned cvt_pk_bf16(float lo, float hi) { unsigned r; asm volatile("v_cvt_pk_bf16_f32 %0, %1, %2" : "=v"(r) : "v"(lo), "v"(hi)); return r; }
typedef float f32x2 __attribute__((ext_vector_type(2)));

template <class Epi, class Sched, bool ALIGN_EPI = false, bool SP2 = false>
__device__ __forceinline__ void gemm_phase(PG8_LAS unsigned char* lds, const Gemm g, const Sched& S, const Epi& E) {
    int tid_o = threadIdx.x; asm volatile("" : "+v"(tid_o));
    const int tid = tid_o, wid = __builtin_amdgcn_readfirstlane(tid >> 6), lane = tid & 63, wr = wid >> 2, wc = wid & 3, fr = lane & 15, fq = lane >> 4;
    const int K = g.K, nt = K / BK, bsh = g.bshift;
    unsigned voffA[2], voffB[2];
#pragma unroll
    for (int i = 0; i < 2; ++i) { int R, C; stage_rc(tid * 16 + i * 8192, R, C); int Rb = Epi::PERM ? ((R & ~31) + perm32(R & 31)) : R; if (bsh) { const int cnt = 256 >> bsh; Rb = ((Rb & (cnt - 1)) << bsh) + (Rb >> (8 - bsh)); }
        voffA[i] = (unsigned)(R * K + C) * 2u; voffB[i] = (unsigned)(Rb * K + C) * 2u; }
    const size_t kstep = (size_t)(BK * 2);
    const size_t hstep = (size_t)HALF * K * 2;
    const size_t hstepB = bsh ? ((size_t)(1 << (bsh - 1)) * K * 2) : hstep;
    const size_t tstep = 2 * hstep;
    const unsigned ldsw = (unsigned)wid * 1024u;
    const int aoff = lds_byte(wr * 64 + fr, fq * 8), boff = lds_byte(wc * 32 + fr, fq * 8);
#define PG8_SA(b, h) (((b) * 2 + (h)) * HTB)
#define PG8_SB(b, h) ((4 + (b) * 2 + (h)) * HTB)
#define PG8_STAGE(bufoff, gbase, voff) do { _Pragma("unroll") for (int _i = 0; _i < 2; ++_i) \
        __builtin_amdgcn_global_load_lds((const unsigned*)((const char*)(gbase) + (voff)[_i]), (PG8_LAS unsigned*)(lds + (bufoff) + ldsw + _i * 8192), 16, 0, 0); } while (0)
#define PG8_LDA(dst, b, h) do { _Pragma("unroll") for (int m = 0; m < 4; ++m) _Pragma("unroll") for (int k = 0; k < 2; ++k) dst[m][k] = *(const PG8_LAS bf16x8*)(lds + PG8_SA(b, h) + aoff + m * 2048 + k * 1024); } while (0)
#define PG8_LDB(dst, b, h) do { _Pragma("unroll") for (int n = 0; n < 2; ++n) _Pragma("unroll") for (int k = 0; k < 2; ++k) dst[n][k] = *(const PG8_LAS bf16x8*)(lds + PG8_SB(b, h) + boff + n * 2048 + k * 1024); } while (0)
#define PG8_MMA(ai, bj, At, Bt) do { __builtin_amdgcn_s_setprio(1); _Pragma("unroll") for (int m = 0; m < 4; ++m) _Pragma("unroll") for (int n = 0; n < 2; ++n) _Pragma("unroll") for (int k = 0; k < 2; ++k) \
        acc[ai][bj][m][n] = __builtin_amdgcn_mfma_f32_16x16x32_bf16(Bt[n][k], At[m][k], acc[ai][bj][m][n], 0, 0, 0); __builtin_amdgcn_s_setprio(0); } while (0)
#define PG8_WAIT_V(n) asm volatile("s_waitcnt vmcnt(" #n ")" ::: "memory")
#define PG8_WAIT_L(n) asm volatile("s_waitcnt lgkmcnt(" #n ")" ::: "memory")
#define PG8_BAR __builtin_amdgcn_s_barrier()
#define PG8_SCHED __builtin_amdgcn_sched_barrier(0)
    Unit cur, nxt; int ui = 0;
    if (!S.next(0, cur)) return;
    f32x4 acc[2][2][4][2];
#pragma unroll
    for (int a = 0; a < 2; ++a)
#pragma unroll
        for (int b = 0; b < 2; ++b)
#pragma unroll
            for (int m = 0; m < 4; ++m)
#pragma unroll
                for (int n = 0; n < 2; ++n) acc[a][b][m][n] = (f32x4){0.f, 0.f, 0.f, 0.f};
    bf16x8 At[4][2], B0[2][2], B1[2][2];
    const char* cA = (const char*)g.A + (size_t)cur.pm * tstep; const char* cB = (const char*)g.Bt + (size_t)cur.pn * tstep;
    S.a_ready(cur);
    if constexpr (SP2) {
        PG8_STAGE(PG8_SB(0, 0), cB, voffB); PG8_STAGE(PG8_SB(0, 1), cB + hstepB, voffB); PG8_STAGE(PG8_SA(0, 0), cA, voffA); PG8_STAGE(PG8_SA(0, 1), cA + hstep, voffA);
        if (wr == 1) PG8_BAR;
        PG8_WAIT_V(2); PG8_BAR;
        PG8_STAGE(PG8_SB(1, 0), cB + kstep, voffB); PG8_STAGE(PG8_SA(1, 0), cA + kstep, voffA); PG8_STAGE(PG8_SB(1, 1), cB + hstepB + kstep, voffB);
        PG8_WAIT_V(6); PG8_BAR;
    } else {
        PG8_STAGE(PG8_SB(0, 0), cB, voffB); PG8_STAGE(PG8_SA(0, 0), cA, voffA); PG8_STAGE(PG8_SB(0, 1), cB + hstepB, voffB); PG8_STAGE(PG8_SA(0, 1), cA + hstep, voffA);
        if (wr == 1) PG8_BAR;
        PG8_WAIT_V(4); PG8_BAR;
        PG8_STAGE(PG8_SB(1, 0), cB + kstep, voffB); PG8_STAGE(PG8_SA(1, 0), cA + kstep, voffA); PG8_STAGE(PG8_SB(1, 1), cB + hstepB + kstep, voffB);
        PG8_WAIT_V(6); PG8_BAR;
    }
    for (;;) {
        const bool has_next = S.next(ui + 1, nxt);
        const char* nA = has_next ? (const char*)g.A + (size_t)nxt.pm * tstep : cA; const char* nB = has_next ? (const char*)g.Bt + (size_t)nxt.pn * tstep : cB;
        for (int t = 0; t < nt; t += 2) {
            const bool last = (t == nt - 2);
            const char* a1 = cA + (size_t)(t + 1) * kstep;
            const char* a2 = last ? nA : cA + (size_t)(t + 2) * kstep; const char* b2 = last ? nB : cB + (size_t)(t + 2) * kstep;
            const char* a3 = a2 + kstep; const char* b3 = b2 + kstep;
            if (last && has_next) S.a_ready(nxt);
            if constexpr (SP2) {
            PG8_LDB(B0, 0, 0); PG8_LDB(B1, 0, 1); PG8_SCHED; PG8_LDA(At, 0, 0); PG8_STAGE(PG8_SA(1, 1), a1 + hstep, voffA);
            PG8_WAIT_V(8); PG8_WAIT_L(0); PG8_BAR; PG8_MMA(0, 0, At, B0); PG8_MMA(0, 1, At, B1); PG8_BAR; PG8_SCHED;
            PG8_LDA(At, 0, 1); PG8_STAGE(PG8_SB(0, 0), b2, voffB); PG8_STAGE(PG8_SB(0, 1), b2 + hstepB, voffB); PG8_STAGE(PG8_SA(0, 0), a2, voffA);
            PG8_WAIT_V(8); PG8_WAIT_L(0); PG8_BAR; PG8_MMA(1, 0, At, B0); PG8_MMA(1, 1, At, B1); PG8_BAR; PG8_SCHED;
            PG8_LDB(B0, 1, 0); PG8_LDB(B1, 1, 1); PG8_SCHED; PG8_LDA(At, 1, 0); PG8_STAGE(PG8_SA(0, 1), a2 + hstep, voffA);
            PG8_WAIT_V(8); PG8_WAIT_L(0); PG8_BAR; PG8_MMA(0, 0, At, B0); PG8_MMA(0, 1, At, B1); PG8_BAR; PG8_SCHED;
            PG8_LDA(At, 1, 1); PG8_STAGE(PG8_SB(1, 0), b3, voffB); PG8_STAGE(PG8_SB(1, 1), b3 + hstepB, voffB); PG8_STAGE(PG8_SA(1, 0), a3, voffA);
            PG8_WAIT_V(8); PG8_WAIT_L(0); PG8_BAR; PG8_MMA(1, 0, At, B0); PG8_MMA(1, 1, At, B1); PG8_BAR; PG8_SCHED;
            } else {
            PG8_LDB(B0, 0, 0); PG8_SCHED; PG8_LDA(At, 0, 0); PG8_STAGE(PG8_SA(1, 1), a1 + hstep, voffA);
            PG8_WAIT_L(8); PG8_BAR; PG8_WAIT_L(0); PG8_MMA(0, 0, At, B0); PG8_BAR; PG8_SCHED;
            PG8_LDB(B1, 0, 1); PG8_STAGE(PG8_SB(0, 0), b2, voffB);
            PG8_BAR; PG8_WAIT_L(0); PG8_MMA(0, 1, At, B1); PG8_BAR;
            PG8_LDA(At, 0, 1); PG8_STAGE(PG8_SA(0, 0), a2, voffA);
            PG8_BAR; PG8_WAIT_L(0); PG8_MMA(1, 0, At, B0); PG8_BAR; PG8_SCHED;
            PG8_STAGE(PG8_SB(0, 1), b2 + hstepB, voffB);
            PG8_WAIT_V(6); PG8_BAR; PG8_MMA(1, 1, At, B1); PG8_BAR;
            PG8_LDB(B0, 1, 0); PG8_SCHED; PG8_LDA(At, 1, 0); PG8_STAGE(PG8_SA(0, 1), a2 + hstep, voffA);
            PG8_WAIT_L(8); PG8_BAR; PG8_WAIT_L(0); PG8_MMA(0, 0, At, B0); PG8_BAR; PG8_SCHED;
            PG8_LDB(B1, 1, 1); PG8_STAGE(PG8_SB(1, 0), b3, voffB);
            PG8_BAR; PG8_WAIT_L(0); PG8_MMA(0, 1, At, B1); PG8_BAR;
            PG8_LDA(At, 1, 1); PG8_STAGE(PG8_SA(1, 0), a3, voffA);
            PG8_BAR; PG8_WAIT_L(0); PG8_MMA(1, 0, At, B0); PG8_BAR; PG8_SCHED;
            PG8_STAGE(PG8_SB(1, 1), b3 + hstepB, voffB);
            PG8_WAIT_V(6); PG8_BAR; PG8_MMA(1, 1, At, B1); PG8_BAR;
            }
        }
        if constexpr (ALIGN_EPI) { if (wr == 0) PG8_BAR; }
        if constexpr (!Epi::AFTER_DRAIN) { E(acc, cur, wr, wc, fr, fq); S.done(cur); }
        if (!has_next) break;
#pragma unroll
        for (int a = 0; a < 2; ++a)
#pragma unroll
            for (int b = 0; b < 2; ++b)
#pragma unroll
                for (int m = 0; m < 4; ++m)
#pragma unroll
                    for (int n = 0; n < 2; ++n) acc[a][b][m][n] = (f32x4){0.f, 0.f, 0.f, 0.f};
        cur = nxt; cA = nA; cB = nB; ++ui;
        if constexpr (ALIGN_EPI) { if (wr == 1) PG8_BAR; }
    }
    PG8_WAIT_V(0);
    if constexpr (!ALIGN_EPI) { if (wr == 0) PG8_BAR; }
    PG8_BAR;
    if constexpr (Epi::AFTER_DRAIN) { E.fused(acc, cur, wr, wc, fr, fq, lds, wid, lane); S.done(cur); }
#undef PG8_SA
#undef PG8_SB
#undef PG8_STAGE
#undef PG8_LDA
#undef PG8_LDB
#undef PG8_MMA
#undef PG8_WAIT_V
#undef PG8_WAIT_L
#undef PG8_BAR
#undef PG8_SCHED
}
}

constexpr int NWAVES = 8, NTHR = NWAVES * 64;
constexpr int BATCH = 4, SEQ = 8192, DM = 1024, DEPTH = 2, T = BATCH * SEQ;
constexpr int INW = 7168, DFF = 2816, NMOD = 6 * DM;
constexpr int NQKP = 3 * 1024 + 512;
constexpr float ALPHA = 1.41421356237309515f;
constexpr float LN_EPS = 1e-5f;
constexpr size_t MiB = 1u << 20;
constexpr size_t WS_MOD = 0;
constexpr size_t WS_BAR = 512 * 1024;
constexpr size_t WS_W = 1 * MiB;
constexpr size_t OW_QK = 0, OW_V = 7 * MiB, OW_G = 10 * MiB, OW_ATT = 14 * MiB, OW_PC = 15 * MiB, OW_O = 16 * MiB, OW_FI = 18 * MiB, OW_FO = 29 * MiB, LW = 34 * MiB + 512 * 1024;
constexpr size_t WS_H = WS_W + 2 * LW;
constexpr size_t WS_R2 = WS_H + 64 * MiB;
constexpr size_t WS_R3 = WS_R2 + 192 * MiB;
constexpr size_t WS_PIN = WS_R3 + 96 * MiB;
constexpr size_t WS_LSE = WS_PIN + 32 * MiB;
constexpr size_t WS_END = WS_LSE + 3 * MiB;
static_assert(WS_END <= 512 * MiB, "workspace map");
static_assert(OW_FO + (size_t)DM * DFF * 2 <= LW, "weight map");
constexpr int LDS_BYTES = 147456;

#define GAS __attribute__((address_space(1)))
#define LAS __attribute__((address_space(3)))
typedef unsigned short bf16;
typedef unsigned v4u __attribute__((ext_vector_type(4)));
typedef unsigned v2u __attribute__((ext_vector_type(2)));
typedef float f32x4 __attribute__((ext_vector_type(4)));
typedef float f32x16 __attribute__((ext_vector_type(16)));
typedef short bf16x8 __attribute__((ext_vector_type(8)));
typedef short s16x4 __attribute__((ext_vector_type(4)));
#define LDS_WAIT() asm volatile("s_waitcnt lgkmcnt(0)" ::: "memory")
__device__ __forceinline__ unsigned f2bf(float f) { unsigned u = __builtin_bit_cast(unsigned, f); return (u + 0x7fffu + ((u >> 16) & 1u)) >> 16; }
__device__ __forceinline__ unsigned pk2(float lo, float hi) { return f2bf(lo) | (f2bf(hi) << 16); }
__device__ __forceinline__ float bflo(unsigned w) { return __builtin_bit_cast(float, w << 16); }
__device__ __forceinline__ float bfhi(unsigned w) { return __builtin_bit_cast(float, w & 0xffff0000u); }
__device__ __forceinline__ float sigmoidf_(float x) { return __builtin_amdgcn_rcpf(1.0f + __expf(-x)); }
__device__ __forceinline__ float wave_sum(float v) {
#pragma unroll
    for (int o = 1; o < 64; o <<= 1) v += __shfl_xor(v, o);
    return v;
}
typedef __bf16 bf16x2_t __attribute__((ext_vector_type(2)));
typedef float f32x2_t __attribute__((ext_vector_type(2)));
__device__ __forceinline__ unsigned cvtpk(float lo, float hi) { f32x2_t v = {lo, hi}; bf16x2_t b = __builtin_convertvector(v, bf16x2_t); return __builtin_bit_cast(unsigned, b); }

typedef const f32x4 (&AccRef)[2][2][4][2];
#define CFENCE() asm volatile("" ::: "memory")

struct EpiQKP {
    static constexpr bool PERM = true, AFTER_DRAIN = false;
    bf16* QK; bf16* PIN;
    __device__ __forceinline__ void operator()(AccRef acc, const pg8::Unit& u, int wr, int wc, int fr, int fq) const {
        const int pn = u.pn; const bool isq = pn < 12;
        const int g = pn >> 2, sh = 2 * g, msk = (1 << sh) - 1, L = SEQ >> sh;
        bf16* base = isq ? QK + (size_t)g * T * 1024 + (pn & 3) * 256 : PIN + (pn - 12) * 256;
        const int pitch = isq ? 1024 : 512;
        const int col0 = wc * 32 + 8 * fq;
#pragma unroll
        for (int ai = 0; ai < 2; ++ai)
#pragma unroll
            for (int m = 0; m < 4; ++m) {
                const int r = u.pm * 256 + ai * 128 + wr * 64 + m * 16 + fr;
                unsigned prow = (unsigned)r;
                if (isq) { const int b = r >> 13, t = r & (SEQ - 1); prow = (unsigned)((b << 13) + (t & msk) * L + (t >> sh)); }
                const unsigned off = prow * (unsigned)pitch + (unsigned)col0;
#pragma unroll
                for (int bj = 0; bj < 2; ++bj) { const f32x4 v0 = acc[ai][bj][m][0], v1 = acc[ai][bj][m][1];
                    v4u w; w.x = cvtpk(v0[0], v0[1]); w.y = cvtpk(v0[2], v0[3]); w.z = cvtpk(v1[0], v1[1]); w.w = cvtpk(v1[2], v1[3]);
                    *(v4u*)(base + (off + bj * 128)) = w; }
                CFENCE(); }
    }
};
struct EpiVT {
    static constexpr bool PERM = true, AFTER_DRAIN = false;
    bf16* VTg; int sh;
    __device__ __forceinline__ void operator()(AccRef acc, const pg8::Unit& u, int wr, int wc, int fr, int fq) const {
        const int pn = u.pn, b = pn >> 5, tb = (pn & 31) * 256, L = SEQ >> sh, cntm = (256 >> sh) - 1;
#pragma unroll
        for (int ai = 0; ai < 2; ++ai)
#pragma unroll
            for (int m = 0; m < 4; ++m) {
                const int r = u.pm * 256 + ai * 128 + wr * 64 + m * 16 + fr;
                const unsigned roff = (unsigned)r * (unsigned)T + (unsigned)(b * SEQ + (tb >> sh));
#pragma unroll
                for (int bj = 0; bj < 2; ++bj) { const int s = bj * 128 + wc * 32 + 8 * fq, p = s >> (8 - sh), i = s & cntm;
                    const f32x4 v0 = acc[ai][bj][m][0], v1 = acc[ai][bj][m][1];
                    v4u w; w.x = cvtpk(v0[0], v0[1]); w.y = cvtpk(v0[2], v0[3]); w.z = cvtpk(v1[0], v1[1]); w.w = cvtpk(v1[2], v1[3]);
                    *(v4u*)(VTg + (roff + (unsigned)(p * L + i))) = w; }
                CFENCE(); }
    }
};
struct EpiSig {
    static constexpr bool PERM = true, AFTER_DRAIN = false;
    bf16* SG;
    __device__ __forceinline__ void operator()(AccRef acc, const pg8::Unit& u, int wr, int wc, int fr, int fq) const {
        const int col0 = u.pn * 256 + wc * 32 + 8 * fq;
#pragma unroll
        for (int ai = 0; ai < 2; ++ai)
#pragma unroll
            for (int m = 0; m < 4; ++m) {
                const int r = u.pm * 256 + ai * 128 + wr * 64 + m * 16 + fr;
                const unsigned off = (unsigned)r * 2048u + (unsigned)col0;
#pragma unroll
                for (int bj = 0; bj < 2; ++bj) { const f32x4 v0 = acc[ai][bj][m][0], v1 = acc[ai][bj][m][1];
                    v4u w; w.x = cvtpk(sigmoidf_(v0[0]), sigmoidf_(v0[1])); w.y = cvtpk(sigmoidf_(v0[2]), sigmoidf_(v0[3]));
                    w.z = cvtpk(sigmoidf_(v1[0]), sigmoidf_(v1[1])); w.w = cvtpk(sigmoidf_(v1[2]), sigmoidf_(v1[3]));
                    *(v4u*)(SG + (off + bj * 128)) = w; }
                CFENCE(); }
    }
};
template <bool ACCUM> struct EpiMerge {
    static constexpr bool PERM = true, AFTER_DRAIN = false;
    const bf16* SG; bf16* MG; int goff;
    __device__ __forceinline__ void operator()(AccRef acc, const pg8::Unit& u, int wr, int wc, int fr, int fq) const {
        const int col0 = u.pn * 256 + wc * 32 + 8 * fq;
#pragma unroll
        for (int ai = 0; ai < 2; ++ai)
#pragma unroll
            for (int m = 0; m < 4; ++m) {
                const int r = u.pm * 256 + ai * 128 + wr * 64 + m * 16 + fr;
                const unsigned so = (unsigned)r * 2048u + (unsigned)(goff + col0), mo = (unsigned)r * 1024u + (unsigned)col0;
#pragma unroll
                for (int bj = 0; bj < 2; ++bj) { const f32x4 v0 = acc[ai][bj][m][0], v1 = acc[ai][bj][m][1];
                    const v4u s = *(const v4u*)(SG + (so + bj * 128));
                    float o0 = bflo(s.x) * v0[0], o1 = bfhi(s.x) * v0[1], o2 = bflo(s.y) * v0[2], o3 = bfhi(s.y) * v0[3];
                    float o4 = bflo(s.z) * v1[0], o5 = bfhi(s.z) * v1[1], o6 = bflo(s.w) * v1[2], o7 = bfhi(s.w) * v1[3];
                    if (ACCUM) { const v4u q = *(const v4u*)(MG + (mo + bj * 128));
                        o0 += bflo(q.x); o1 += bfhi(q.x); o2 += bflo(q.y); o3 += bfhi(q.y); o4 += bflo(q.z); o5 += bfhi(q.z); o6 += bflo(q.w); o7 += bfhi(q.w); }
                    v4u w; w.x = cvtpk(o0, o1); w.y = cvtpk(o2, o3); w.z = cvtpk(o4, o5); w.w = cvtpk(o6, o7);
                    *(v4u*)(MG + (mo + bj * 128)) = w; }
                CFENCE(); }
    }
};
struct EpiRes {
    static constexpr bool PERM = false, AFTER_DRAIN = false;
    const float* xin; float* XB; const float* gate;
    __device__ __forceinline__ void operator()(AccRef acc, const pg8::Unit& u, int wr, int wc, int fr, int fq) const {
        const int col0 = u.pn * 256 + wc * 32 + 4 * fq; const int b = u.pm >> 5;
        f32x4 gv[2][2];
#pragma unroll
        for (int bj = 0; bj < 2; ++bj)
#pragma unroll
            for (int n = 0; n < 2; ++n) gv[bj][n] = *(const f32x4*)(gate + (unsigned)(b * NMOD + col0 + bj * 128 + n * 16)) + 1.0f;
#pragma unroll
        for (int ai = 0; ai < 2; ++ai)
#pragma unroll
            for (int m = 0; m < 4; ++m) {
                const int r = u.pm * 256 + ai * 128 + wr * 64 + m * 16 + fr; const unsigned off = (unsigned)r * (unsigned)DM + (unsigned)col0;
#pragma unroll
                for (int bj = 0; bj < 2; ++bj)
#pragma unroll
                    for (int n = 0; n < 2; ++n) { const f32x4 xv = *(const f32x4*)(xin + off + bj * 128 + n * 16);
                        *(f32x4*)(XB + off + bj * 128 + n * 16) = xv * ALPHA + gv[bj][n] * acc[ai][bj][m][n]; }
                CFENCE(); }
    }
};
struct EpiSwiGLU {
    static constexpr bool PERM = true, AFTER_DRAIN = false;
    bf16* HID;
    __device__ __forceinline__ void operator()(AccRef acc, const pg8::Unit& u, int wr, int wc, int fr, int fq) const {
        const int col0 = u.pn * 128 + wc * 32 + 8 * fq;
#pragma unroll
        for (int ai = 0; ai < 2; ++ai)
#pragma unroll
            for (int m = 0; m < 4; ++m) {
                const int r = u.pm * 256 + ai * 128 + wr * 64 + m * 16 + fr;
                float o[8];
#pragma unroll
                for (int n = 0; n < 2; ++n)
#pragma unroll
                    for (int e = 0; e < 4; ++e) { const float a = acc[ai][0][m][n][e], bb = acc[ai][1][m][n][e]; o[4 * n + e] = a * sigmoidf_(a) * bb; }
                v4u w; w.x = cvtpk(o[0], o[1]); w.y = cvtpk(o[2], o[3]); w.z = cvtpk(o[4], o[5]); w.w = cvtpk(o[6], o[7]);
                *(v4u*)(HID + ((unsigned)r * (unsigned)DFF + (unsigned)col0)) = w; CFENCE(); }
    }
};

template <int MAP> __device__ __forceinline__ int srccol(int n) {
    if (MAP == 1) { return n < 3072 ? (n >> 10) * 1536 + (n & 1023) : 4608 + (n - 3072); }
    if (MAP == 2) { return (n >> 9) * 1536 + 1024 + (n & 511); }
    if (MAP == 3) { return 5120 + n; }
    if (MAP == 4) { return ((n >> 7) & 1) * DFF + (n >> 8) * 128 + (n & 127); }
    return n;
}
template <int MAP> __device__ __forceinline__ void transpose_mat(const float* W, int K, int Nsrc, bf16* WT, int Ndst, LAS float* scr, int gw, int NGW, int lane) {
    const int nblk = Ndst / 32, nitems = (K / 64) * nblk;
    for (int item = gw; item < nitems; item += NGW) {
        const int kb = item / nblk, nb = item % nblk, k0 = 64 * kb, n0 = 32 * nb, s0 = srccol<MAP>(n0);
#pragma unroll 8
        for (int i = 0; i < 32; ++i) { const int kk = 2 * i + (lane >> 5); scr[kk * 33 + (lane & 31)] = W[(size_t)(k0 + kk) * Nsrc + s0 + (lane & 31)]; }
        LDS_WAIT(); asm volatile("" ::: "memory");
        const int c = lane & 7;
#pragma unroll
        for (int j = 0; j < 4; ++j) { const int n = (lane >> 3) + 8 * j; const LAS float* s = scr + (8 * c) * 33 + n;
            v4u o; o.x = pk2(s[0 * 33], s[1 * 33]); o.y = pk2(s[2 * 33], s[3 * 33]); o.z = pk2(s[4 * 33], s[5 * 33]); o.w = pk2(s[6 * 33], s[7 * 33]);
            *(v4u*)(WT + (size_t)(n0 + n) * K + k0 + 8 * c) = o; }
        LDS_WAIT(); asm volatile("" ::: "memory");
    }
}
struct Args { const float* in[16]; float* out; unsigned char* ws; };

__device__ __forceinline__ void p0_prologue(const Args& A, LAS unsigned char* lds, int tid, int lane, int wave, int G) {
    LAS float* scr = (LAS float*)(lds + wave * 16384);
    const int gw = blockIdx.x * NWAVES + wave, NGW = G * NWAVES;
    for (int l = 0; l < DEPTH; ++l) {
        unsigned char* wl = A.ws + WS_W + (size_t)l * LW;
        const float* w_in = A.in[4] + (size_t)l * DM * INW;
        transpose_mat<1>(w_in, DM, INW, (bf16*)(wl + OW_QK), NQKP, scr, gw, NGW, lane);
        transpose_mat<2>(w_in, DM, INW, (bf16*)(wl + OW_V), 1536, scr, gw, NGW, lane);
        transpose_mat<3>(w_in, DM, INW, (bf16*)(wl + OW_G), 2048, scr, gw, NGW, lane);
        transpose_mat<0>(A.in[7] + (size_t)l * 512 * DM, 512, DM, (bf16*)(wl + OW_ATT), DM, scr, gw, NGW, lane);
        transpose_mat<0>(A.in[9] + (size_t)l * DM * DM, DM, DM, (bf16*)(wl + OW_O), DM, scr, gw, NGW, lane);
        transpose_mat<4>(A.in[12] + (size_t)l * DM * 2 * DFF, DM, 2 * DFF, (bf16*)(wl + OW_FI), 2 * DFF, scr, gw, NGW, lane);
        transpose_mat<0>(A.in[13] + (size_t)l * DFF * DM, DFF, DM, (bf16*)(wl + OW_FO), DM, scr, gw, NGW, lane);
        const float* mix = A.in[5] + (size_t)l * 4 * 128 * 128; const float* psc = A.in[6] + (size_t)l * 512; const float* wpo = A.in[8] + (size_t)l * 512 * DM;
        bf16* wpc = (bf16*)(wl + OW_PC);
        for (int o = (blockIdx.x * NTHR + tid); o < 128 * DM; o += G * NTHR) {
            const int n = o & 1023, k4 = (o >> 10) * 4, gg = k4 >> 7; float a0 = 0.f, a1 = 0.f, a2 = 0.f, a3 = 0.f;
            const float* mr = mix + (size_t)gg * 128 * 128 + (size_t)(k4 & 127) * 128;
            for (int j = 0; j < 128; ++j) { const float wv = psc[gg * 128 + j] * wpo[(size_t)(gg * 128 + j) * DM + n];
                a0 += mr[j] * wv; a1 += mr[128 + j] * wv; a2 += mr[256 + j] * wv; a3 += mr[384 + j] * wv; }
            v2u w; w.x = pk2(a0, a1); w.y = pk2(a2, a3); *(v2u*)(wpc + (size_t)n * 512 + k4) = w;
        }
    }
    __syncthreads();
    {
        LAS float* red = (LAS float*)lds;
        const float* c = A.in[1]; float* MOD = (float*)(A.ws + WS_MOD);
        const int ks = tid >> 6, col = tid & 63;
        for (int item = blockIdx.x; item < DEPTH * NMOD / 64; item += G) {
            const int l = item / (NMOD / 64), n = (item % (NMOD / 64)) * 64 + col;
            const float* w = A.in[2] + (size_t)l * DM * NMOD + n;
            float a0 = 0.f, a1 = 0.f, a2 = 0.f, a3 = 0.f;
            for (int k = ks * 128; k < ks * 128 + 128; ++k) { const float wv = w[(size_t)k * NMOD];
                const float c0 = c[k], c1 = c[DM + k], c2 = c[2 * DM + k], c3 = c[3 * DM + k];
                a0 += c0 * sigmoidf_(c0) * wv; a1 += c1 * sigmoidf_(c1) * wv; a2 += c2 * sigmoidf_(c2) * wv; a3 += c3 * sigmoidf_(c3) * wv; }
            red[(ks * 4 + 0) * 64 + col] = a0; red[(ks * 4 + 1) * 64 + col] = a1; red[(ks * 4 + 2) * 64 + col] = a2; red[(ks * 4 + 3) * 64 + col] = a3;
            __syncthreads();
            if (tid < 256) { const int b = tid >> 6; float s = 0.f;
#pragma unroll
                for (int q = 0; q < 8; ++q) s += red[(q * 4 + b) * 64 + col];
                MOD[((size_t)l * BATCH + b) * NMOD + n] = s + A.in[3][(size_t)l * NMOD + n]; }
            __syncthreads();
        }
    }
}

template <int MODE> __device__ __forceinline__ void ln_pass(const float* in, float* out, bf16* H, const float* lg, const float* lb, const float* sc, const float* sh, int gw, int NGW, int lane_) {
    int lane = lane_; asm volatile("" : "+v"(lane));
    for (int row = gw; row < T; row += NGW) {
        const int b = row >> 13;
        const f32x4* xr = (const f32x4*)(in + (size_t)row * DM) + lane;
        f32x4 v[4]; float s = 0.f;
#pragma unroll
        for (int j = 0; j < 4; ++j) { v[j] = xr[64 * j]; s += (v[j].x + v[j].y) + (v[j].z + v[j].w); }
        float mean = wave_sum(s) * (1.f / DM), s2 = 0.f;
#pragma unroll
        for (int j = 0; j < 4; ++j) { v[j] = v[j] - mean; s2 += (v[j].x * v[j].x + v[j].y * v[j].y) + (v[j].z * v[j].z + v[j].w * v[j].w); }
        float rstd = 1.f / sqrtf(wave_sum(s2) * (1.f / DM) + LN_EPS);
        if (MODE != 0) {
            f32x4* orow = (f32x4*)(out + (size_t)row * DM) + lane; s = 0.f;
#pragma unroll
            for (int j = 0; j < 4; ++j) { const f32x4 gg = ((const f32x4*)lg)[lane + 64 * j], bb = ((const f32x4*)lb)[lane + 64 * j];
                v[j] = v[j] * rstd * gg + bb; orow[64 * j] = v[j]; s += (v[j].x + v[j].y) + (v[j].z + v[j].w); }
            if (MODE == 2) continue;
            mean = wave_sum(s) * (1.f / DM); s2 = 0.f;
#pragma unroll
            for (int j = 0; j < 4; ++j) { v[j] = v[j] - mean; s2 += (v[j].x * v[j].x + v[j].y * v[j].y) + (v[j].z * v[j].z + v[j].w * v[j].w); }
            rstd = 1.f / sqrtf(wave_sum(s2) * (1.f / DM) + LN_EPS);
        }
        v2u* hrow = (v2u*)(H + (size_t)row * DM) + lane;
#pragma unroll
        for (int j = 0; j < 4; ++j) { const f32x4 a = ((const f32x4*)(sc + (size_t)b * NMOD))[lane + 64 * j] + 1.0f, d = ((const f32x4*)(sh + (size_t)b * NMOD))[lane + 64 * j];
            const f32x4 h = v[j] * rstd * a + d; v2u w; w.x = pk2(h.x, h.y); w.y = pk2(h.z, h.w); hrow[64 * j] = w; }
    }
}

#define MFMA32(a, b, c) __builtin_amdgcn_mfma_f32_32x32x16_bf16((a), (b), (c), 0, 0, 0)
__device__ __forceinline__ void attn_unit(bf16* QKg, const bf16* VTg, float* LSEg, int b, int h, int p, int qb, int sh, float sr, int lane_) {
    int lane = lane_; asm volatile("" : "+v"(lane));
    const int L = SEQ >> sh, a = lane & 31, hi = lane >> 5, q0 = qb * 32;
    const unsigned rowbase = (unsigned)(b * SEQ + p * L);
    const unsigned qoff = (rowbase + (unsigned)(q0 + a)) * 1024u + (unsigned)(h * 64);
    bf16x8 qf[4];
#pragma unroll
    for (int s = 0; s < 4; ++s) qf[s] = *(const bf16x8*)(QKg + (qoff + (unsigned)(16 * s + 8 * hi)));
    f32x16 st[5];
    float mx = -1e30f;
#pragma unroll
    for (int j = 0; j < 5; ++j) {
        const int kt0 = q0 - 64 + 32 * j; const bool inr = (kt0 >= 0) && (kt0 < L);
        f32x16 acc;
#pragma unroll
        for (int e = 0; e < 16; ++e) acc[e] = 0.f;
        if (inr) {
            const unsigned koff = qoff + (unsigned)((32 * j - 64) * 1024 + 512 + 8 * hi);
            bf16x8 kf[4];
#pragma unroll
            for (int s = 0; s < 4; ++s) kf[s] = *(const bf16x8*)(QKg + (koff + (unsigned)(16 * s)));
#pragma unroll
            for (int s = 0; s < 4; ++s) acc = MFMA32(kf[s], qf[s], acc);
        }
#pragma unroll
        for (int e = 0; e < 16; ++e) {
            const int c = (e & 3) + 8 * (e >> 2) + 4 * hi, rel = 32 * j - 64 + c - a, ar = rel < 0 ? -rel : rel;
            float v = acc[e] * 0.125f - sr * (float)ar;
            if (j == 0) v += fminf((float)(c - a), 0.f) * 1e30f;
            if (j == 4) v += fminf((float)(a - c), 0.f) * 1e30f;
            if (!inr) v = -1e30f;
            acc[e] = v; mx = fmaxf(mx, v);
        }
        st[j] = acc;
    }
    mx = fmaxf(mx, __shfl_xor(mx, 32));
    float lsum = 0.f;
#pragma unroll
    for (int j = 0; j < 5; ++j)
#pragma unroll
        for (int e = 0; e < 16; ++e) { const float pv = __expf(st[j][e] - mx); st[j][e] = pv; lsum += pv; }
    lsum += __shfl_xor(lsum, 32);
    f32x16 o0, o1;
#pragma unroll
    for (int e = 0; e < 16; ++e) { o0[e] = 0.f; o1[e] = 0.f; }
    const unsigned voff = (unsigned)(h * 64 + a) * (unsigned)T + rowbase + (unsigned)(q0 - 64 + 4 * hi) ;
#pragma unroll
    for (int j = 0; j < 5; ++j) {
        const int kt0 = q0 - 64 + 32 * j; const bool inr = (kt0 >= 0) && (kt0 < L);
        if (inr) {
#pragma unroll
            for (int s2 = 0; s2 < 2; ++s2) {
                v4u pw; pw.x = cvtpk(st[j][8 * s2 + 0], st[j][8 * s2 + 1]); pw.y = cvtpk(st[j][8 * s2 + 2], st[j][8 * s2 + 3]);
                pw.z = cvtpk(st[j][8 * s2 + 4], st[j][8 * s2 + 5]); pw.w = cvtpk(st[j][8 * s2 + 6], st[j][8 * s2 + 7]);
                const bf16x8 pf = __builtin_bit_cast(bf16x8, pw);
                const unsigned vo = voff + (unsigned)(32 * j + 16 * s2);
                v4u va, vb;
                { const v2u x0 = *(const v2u*)(VTg + vo), x1 = *(const v2u*)(VTg + (vo + 8u)); va.x = x0.x; va.y = x0.y; va.z = x1.x; va.w = x1.y; }
                { const v2u x0 = *(const v2u*)(VTg + (vo + 32u * (unsigned)T)), x1 = *(const v2u*)(VTg + (vo + 32u * (unsigned)T + 8u)); vb.x = x0.x; vb.y = x0.y; vb.z = x1.x; vb.w = x1.y; }
                o0 = MFMA32(__builtin_bit_cast(bf16x8, va), pf, o0);
                o1 = MFMA32(__builtin_bit_cast(bf16x8, vb), pf, o1);
            }
        }
    }
    const float inv = 1.0f / lsum;
#pragma unroll
    for (int gq = 0; gq < 4; ++gq) {
        v2u w0, w1;
        w0.x = cvtpk(o0[4 * gq] * inv, o0[4 * gq + 1] * inv); w0.y = cvtpk(o0[4 * gq + 2] * inv, o0[4 * gq + 3] * inv);
        w1.x = cvtpk(o1[4 * gq] * inv, o1[4 * gq + 1] * inv); w1.y = cvtpk(o1[4 * gq + 2] * inv, o1[4 * gq + 3] * inv);
        *(v2u*)(QKg + (qoff + (unsigned)(8 * gq + 4 * hi))) = w0; *(v2u*)(QKg + (qoff + (unsigned)(32 + 8 * gq + 4 * hi))) = w1;
    }
    if (hi == 0) LSEg[((unsigned)(b * SEQ + p) + ((unsigned)(q0 + a) << sh)) * 8u + (unsigned)h] = mx + __logf(lsum);
}
__device__ __forceinline__ void attn_phase(bf16* QK, const bf16* VT, float* LSE, int gw, int NGW, int lane_) {
    int lane = lane_; asm volatile("" : "+v"(lane));
    constexpr int NU = 3 * BATCH * 8 * 256;
    for (int u = gw; u < NU; u += NGW) {
        const int pq = u & 255, h = (u >> 8) & 7, b = (u >> 11) & 3, g = u >> 13, sh = 2 * g, L32 = (SEQ >> sh) >> 5;
        const int p = pq / L32, qb = pq % L32;
        const float slope = exp2f(-8.0f * (float)(g * 8 + h + 1) / 24.0f);
        attn_unit(QK + (size_t)g * T * 1024, VT + (size_t)g * 512 * T, LSE + (size_t)g * T * 8, b, h, p, qb, sh, slope * (float)(1 << sh), lane);
    }
}

__device__ __forceinline__ void combine_pool_phase(const bf16* QK, const float* LSE, const bf16* PIN, bf16* ATT, bf16* POOLED, int gw, int NGW, int lane_) {
    int lane = lane_; asm volatile("" : "+v"(lane));
    for (int tok = gw; tok < T; tok += NGW) {
        const int b = tok >> 13, t = tok & (SEQ - 1);
        {
            const int hh = lane >> 3, d0 = (lane & 7) * 8;
            const float l0 = LSE[((size_t)0 * T + tok) * 8 + hh], l1 = LSE[((size_t)1 * T + tok) * 8 + hh], l2 = LSE[((size_t)2 * T + tok) * 8 + hh];
            const float m = fmaxf(l0, fmaxf(l1, l2)); float w0 = __expf(l0 - m), w1 = __expf(l1 - m), w2 = __expf(l2 - m);
            const float inv = 1.0f / (w0 + w1 + w2); w0 *= inv; w1 *= inv; w2 *= inv;
            const size_t r0 = (size_t)tok, r1 = ((size_t)b << 13) + (size_t)(t & 3) * (SEQ / 4) + (t >> 2), r2 = ((size_t)b << 13) + (size_t)(t & 15) * (SEQ / 16) + (t >> 4);
            const v4u a0 = *(const v4u*)(QK + r0 * 1024 + hh * 64 + d0), a1 = *(const v4u*)(QK + ((size_t)T + r1) * 1024 + hh * 64 + d0), a2 = *(const v4u*)(QK + ((size_t)2 * T + r2) * 1024 + hh * 64 + d0);
            v4u w;
            w.x = pk2(w0 * bflo(a0.x) + w1 * bflo(a1.x) + w2 * bflo(a2.x), w0 * bfhi(a0.x) + w1 * bfhi(a1.x) + w2 * bfhi(a2.x));
            w.y = pk2(w0 * bflo(a0.y) + w1 * bflo(a1.y) + w2 * bflo(a2.y), w0 * bfhi(a0.y) + w1 * bfhi(a1.y) + w2 * bfhi(a2.y));
            w.z = pk2(w0 * bflo(a0.z) + w1 * bflo(a1.z) + w2 * bflo(a2.z), w0 * bfhi(a0.z) + w1 * bfhi(a1.z) + w2 * bfhi(a2.z));
            w.w = pk2(w0 * bflo(a0.w) + w1 * bflo(a1.w) + w2 * bflo(a2.w), w0 * bfhi(a0.w) + w1 * bfhi(a1.w) + w2 * bfhi(a2.w));
            *(v4u*)(ATT + (size_t)tok * 512 + hh * 64 + d0) = w;
        }
        {
            const int half = 1 << (lane >> 4), lo = (t - half) < 0 ? 0 : (t - half), hi = (t + half) > SEQ ? SEQ : (t + half);
            const bf16* base = PIN + ((size_t)b << 13) * 512 + lane * 8;
            float s[8];
#pragma unroll
            for (int e = 0; e < 8; ++e) s[e] = 0.f;
            for (int tt = lo; tt < hi; ++tt) { const v4u x = *(const v4u*)(base + (size_t)tt * 512);
                s[0] += bflo(x.x); s[1] += bfhi(x.x); s[2] += bflo(x.y); s[3] += bfhi(x.y); s[4] += bflo(x.z); s[5] += bfhi(x.z); s[6] += bflo(x.w); s[7] += bfhi(x.w); }
            const float rc = 1.0f / (float)(hi - lo); const v4u x = *(const v4u*)(base + (size_t)t * 512);
            v4u w; w.x = pk2(s[0] * rc - bflo(x.x), s[1] * rc - bfhi(x.x)); w.y = pk2(s[2] * rc - bflo(x.y), s[3] * rc - bfhi(x.y));
            w.z = pk2(s[4] * rc - bflo(x.z), s[5] * rc - bfhi(x.z)); w.w = pk2(s[6] * rc - bflo(x.w), s[7] * rc - bfhi(x.w));
            *(v4u*)(POOLED + (size_t)tok * 512 + lane * 8) = w;
        }
    }
}

#define XB_TMO      128
#define XB_XCNT(j)  (256  + 64 * (j))
#define XB_XSUB(j)  (1280 + 64 * (j))
#define XB_XGEN(j)  (2304 + 64 * (j))
#define XB_TOP      3328
#define XB_TOPGEN   3392
#define XCD_BAR_WORDS 3456
#define XB_SPIN_CAP (1u << 18)

__device__ __forceinline__ unsigned xb_ld(unsigned* p)              { return __hip_atomic_load(p, __ATOMIC_RELAXED, __HIP_MEMORY_SCOPE_AGENT); }
__device__ __forceinline__ unsigned xb_add(unsigned* p, unsigned v) { return __hip_atomic_fetch_add(p, v, __ATOMIC_RELAXED, __HIP_MEMORY_SCOPE_AGENT); }
__device__ __forceinline__ unsigned xb_xcc_id() { return (unsigned)__builtin_amdgcn_s_getreg((3 << 11) | 20) & 0xFu; }
#define XB_SPIN(cond, bar) do { unsigned _sp = 0; while (cond) { __builtin_amdgcn_s_sleep(1); \
    if ((++_sp & 255u) == 0u) { if (xb_ld(&(bar)[XB_TMO])) break; if (_sp > XB_SPIN_CAP) { atomicAdd(&(bar)[XB_TMO], 1u); break; } } } } while (0)

struct XcdBarrier {
    unsigned* bar; unsigned x;
    volatile LAS unsigned* st;
};

__device__ __forceinline__ XcdBarrier xcd_barrier_post(unsigned* bar, volatile LAS unsigned* st) {
    XcdBarrier b; b.bar = bar; b.x = xb_xcc_id(); b.st = st;
    if (threadIdx.x == 0) (void)xb_add(&bar[XB_XCNT(b.x)], 1u);
    return b;
}
__device__ __forceinline__ void xcd_barrier_complete(unsigned* bar, unsigned x, unsigned& nloc, unsigned& nx) {
    const unsigned G = gridDim.x * gridDim.y * gridDim.z;
    unsigned sum, cnt, mine, sp = 0u;
    for (;;) {
        sum = 0u; cnt = 0u; mine = 0u;
#pragma unroll
        for (unsigned j = 0; j < 16; ++j) { const unsigned c = xb_ld(&bar[XB_XCNT(j)]); sum += c; cnt += (c > 0u) ? 1u : 0u; mine = (j == x) ? c : mine; }
        if (sum == G) break;
        __builtin_amdgcn_s_sleep(1);
        if ((++sp & 255u) == 0u) { if (xb_ld(&bar[XB_TMO])) break; if (sp > XB_SPIN_CAP) { atomicAdd(&bar[XB_TMO], 1u); break; } }
    }
    nloc = mine > 0u ? mine : 1u; nx = cnt > 0u ? cnt : 1u;
}

__device__ __forceinline__ void xcd_barrier(const XcdBarrier& b) {
    asm volatile("s_waitcnt vmcnt(0)" ::: "memory");
    __syncthreads();
    if (threadIdx.x == 0) {
        unsigned* bar = b.bar;
        __builtin_amdgcn_s_waitcnt(0);
        unsigned nloc = b.st[0], nx = b.st[1];
        if (nloc == 0u) { xcd_barrier_complete(bar, b.x, nloc, nx); b.st[0] = nloc; b.st[1] = nx; }
        const unsigned old = xb_add(&bar[XB_XSUB(b.x)], 1u);
        const unsigned gen = old / nloc;
        if (old + 1u == (gen + 1u) * nloc) {
            __builtin_amdgcn_fence(__ATOMIC_RELEASE, "agent");
            asm volatile("s_waitcnt vmcnt(0)" ::: "memory");
            const unsigned og = xb_add(&bar[XB_TOP], 1u);
            const unsigned tg = og / nx;
            if (og + 1u == (tg + 1u) * nx) xb_add(&bar[XB_TOPGEN], 1u);
            else XB_SPIN(xb_ld(&bar[XB_TOPGEN]) == tg, bar);
            __builtin_amdgcn_fence(__ATOMIC_ACQUIRE, "agent");
            xb_add(&bar[XB_XGEN(b.x)], 1u);
            asm volatile("s_waitcnt vmcnt(0)" ::: "memory");
        } else {
            XB_SPIN(xb_ld(&bar[XB_XGEN(b.x)]) == gen, bar);
            __builtin_amdgcn_fence(__ATOMIC_ACQUIRE, "agent");
            asm volatile("s_waitcnt vmcnt(0)" ::: "memory");
        }
    }
    __syncthreads();
}

#ifndef DBG_STAGE
#define DBG_STAGE 0
#endif
__device__ __forceinline__ void dbg_dump(float* out, const bf16* src, int pitch, int ncols, int coloff, int tid, int G) {
    const size_t n = (size_t)T * ncols;
    for (size_t i = (size_t)blockIdx.x * NTHR + tid; i < n; i += (size_t)G * NTHR) { const size_t r = i / ncols, c = i % ncols; out[r * 1024 + coloff + c] = bflo((unsigned)src[r * pitch + c]); }
}
#define DBG(n, stmt) do { if (DBG_STAGE == (n) && l == 0) { GSYNC(); stmt; return; } } while (0)
template <class Epi> __device__ __forceinline__ void run_gemm(LAS unsigned char* lds, const bf16* A, const bf16* Bt, int M, int N, int K, int bshift, int G, const Epi& E) {
    pg8::Gemm g{A, Bt, M, N, K, bshift}; pg8::StaticOrder S; S.init(M, N, G, (int)blockIdx.x);
    pg8::gemm_phase<Epi, pg8::StaticOrder, true, true>(lds, g, S, E);
}

__global__ void __launch_bounds__(NTHR, 2) fwd_megakernel(Args args) {
    extern __shared__ __attribute__((aligned(16))) unsigned char lds_raw[];
    LAS unsigned char* lds = (LAS unsigned char*)lds_raw;
    cg::grid_group grid = cg::this_grid();
    const int tid = threadIdx.x, lane = tid & 63, wave = __builtin_amdgcn_readfirstlane(tid >> 6), G = gridDim.x;
    const int gw = blockIdx.x * NWAVES + wave, NGW = G * NWAVES;
    volatile LAS unsigned* bst = (volatile LAS unsigned*)(lds + 131072 + 1024);
    if (tid == 0) { bst[0] = 0u; bst[1] = 0u; }
    __syncthreads();
    (void)xcd_barrier_post((unsigned*)(args.ws + WS_BAR), bst);
    grid.sync();
#define GSYNC() do { XcdBarrier b_; b_.bar = (unsigned*)(args.ws + WS_BAR); b_.x = xb_xcc_id(); b_.st = (volatile LAS unsigned*)(lds + 131072 + 1024); xcd_barrier(b_); } while (0)
#define OPQ(p) asm volatile("" : "+s"(p))
#define WSP(name) unsigned char* name = args.ws; OPQ(name)
    {   WSP(ws);
        p0_prologue(args, lds, tid, lane, wave, G);
#ifdef DIAG_FILL
        { v4u* z = (v4u*)(ws + WS_H); const size_t n16 = (WS_END - WS_H) / 16; const v4u zero = {0u, 0u, 0u, 0u};
          for (size_t i = (size_t)blockIdx.x * NTHR + tid; i < n16; i += (size_t)G * NTHR) z[i] = zero; }
#endif
        GSYNC();
        float* MOD = (float*)(ws + WS_MOD);
        ln_pass<0>(args.in[0], nullptr, (bf16*)(ws + WS_H), nullptr, nullptr, MOD + 1 * DM, MOD + 0 * DM, gw, NGW, lane);
        GSYNC();
        { const int l = 0; if (DBG_STAGE == 1) { dbg_dump(args.out, (const bf16*)(ws + WS_H), 1024, 1024, 0, tid, G); return; } } }
#pragma unroll 1
    for (int l = 0; l < DEPTH; ++l) {
#ifndef DBG_SKIP_ATT
        {   WSP(ws); const unsigned char* wl = ws + WS_W + (size_t)l * LW;
            EpiQKP E{(bf16*)(ws + WS_R2), (bf16*)(ws + WS_PIN)}; run_gemm(lds, (const bf16*)(ws + WS_H), (const bf16*)(wl + OW_QK), T, NQKP, DM, 0, G, E); }
#pragma unroll 1
        for (int g = 0; g < 3; ++g) { WSP(ws); const unsigned char* wl = ws + WS_W + (size_t)l * LW;
            EpiVT E{(bf16*)(ws + WS_R3) + (size_t)g * 512 * T, 2 * g}; run_gemm(lds, (const bf16*)(wl + OW_V) + (size_t)g * 512 * DM, (const bf16*)(ws + WS_H), 512, T, DM, 2 * g, G, E); }
        DBG(2, dbg_dump(args.out, (const bf16*)(args.ws + WS_R2) + (size_t)T * 1024, 1024, 1024, 0, tid, G));
        DBG(3, dbg_dump(args.out, (const bf16*)(args.ws + WS_R3), 1024, 1024, 0, tid, G));
        GSYNC();
        {   WSP(ws); attn_phase((bf16*)(ws + WS_R2), (const bf16*)(ws + WS_R3), (float*)(ws + WS_LSE), gw, NGW, lane); }
        DBG(4, dbg_dump(args.out, (const bf16*)(args.ws + WS_R2) + (size_t)2 * T * 1024, 1024, 1024, 0, tid, G));
        GSYNC();
        {   WSP(ws); combine_pool_phase((const bf16*)(ws + WS_R2), (const float*)(ws + WS_LSE), (const bf16*)(ws + WS_PIN), (bf16*)(ws + WS_R3), (bf16*)(ws + WS_R3 + 32 * MiB), gw, NGW, lane); }
        DBG(5, { dbg_dump(args.out, (const bf16*)(args.ws + WS_R3), 512, 512, 0, tid, G); dbg_dump(args.out, (const bf16*)(args.ws + WS_R3 + 32 * MiB), 512, 512, 512, tid, G); });
        GSYNC();
#endif
        {   WSP(ws); const unsigned char* wl = ws + WS_W + (size_t)l * LW;
            EpiSig E{(bf16*)(ws + WS_R2)}; run_gemm(lds, (const bf16*)(ws + WS_H), (const bf16*)(wl + OW_G), T, 2048, DM, 0, G, E); }
        DBG(11, dbg_dump(args.out, (const bf16*)(args.ws + WS_R2) + 1024, 2048, 1024, 0, tid, G));
        GSYNC();
        {   WSP(ws); const unsigned char* wl = ws + WS_W + (size_t)l * LW;
            EpiMerge<false> E{(const bf16*)(ws + WS_R2), (bf16*)(ws + WS_R2 + 128 * MiB), 0}; run_gemm(lds, (const bf16*)(ws + WS_R3), (const bf16*)(wl + OW_ATT), T, DM, 512, 0, G, E); }
        DBG(12, dbg_dump(args.out, (const bf16*)(args.ws + WS_R2 + 128 * MiB), 1024, 1024, 0, tid, G));
        GSYNC();
        {   WSP(ws); const unsigned char* wl = ws + WS_W + (size_t)l * LW;
            EpiMerge<true> E{(const bf16*)(ws + WS_R2), (bf16*)(ws + WS_R2 + 128 * MiB), 1024}; run_gemm(lds, (const bf16*)(ws + WS_R3 + 32 * MiB), (const bf16*)(wl + OW_PC), T, DM, 512, 0, G, E); }
        DBG(6, dbg_dump(args.out, (const bf16*)(args.ws + WS_R2 + 128 * MiB), 1024, 1024, 0, tid, G));
        GSYNC();
        {   WSP(ws); const unsigned char* wl = ws + WS_W + (size_t)l * LW; const float* modl = (const float*)(ws + WS_MOD) + (size_t)l * BATCH * NMOD;
            const float* xin = (l == 0) ? args.in[0] : args.out;
            EpiRes E{xin, args.out, modl + 2 * DM}; run_gemm(lds, (const bf16*)(ws + WS_R2 + 128 * MiB), (const bf16*)(wl + OW_O), T, DM, DM, 0, G, E); }
        DBG(7, (void)0);
        GSYNC();
        {   WSP(ws); const float* modl = (const float*)(ws + WS_MOD) + (size_t)l * BATCH * NMOD;
            ln_pass<1>(args.out, args.out, (bf16*)(ws + WS_H), args.in[10] + (size_t)l * DM, args.in[11] + (size_t)l * DM, modl + 4 * DM, modl + 3 * DM, gw, NGW, lane); }
        DBG(8, (void)0);
        GSYNC();
        {   WSP(ws); const unsigned char* wl = ws + WS_W + (size_t)l * LW;
            EpiSwiGLU E{(bf16*)(ws + WS_R2)}; run_gemm(lds, (const bf16*)(ws + WS_H), (const bf16*)(wl + OW_FI), T, 2 * DFF, DM, 0, G, E); }
        DBG(9, dbg_dump(args.out, (const bf16*)(args.ws + WS_R2), DFF, 1024, 0, tid, G));
        GSYNC();
        {   WSP(ws); const unsigned char* wl = ws + WS_W + (size_t)l * LW; const float* modl = (const float*)(ws + WS_MOD) + (size_t)l * BATCH * NMOD;
            EpiRes E{args.out, args.out, modl + 5 * DM}; run_gemm(lds, (const bf16*)(ws + WS_R2), (const bf16*)(wl + OW_FO), T, DM, DFF, 0, G, E); }
        DBG(10, (void)0);
        GSYNC();
        {   WSP(ws); const float* modl = (const float*)(ws + WS_MOD) + (size_t)l * BATCH * NMOD;
            if (l + 1 < DEPTH) ln_pass<1>(args.out, args.out, (bf16*)(ws + WS_H), args.in[14] + (size_t)l * DM, args.in[15] + (size_t)l * DM, modl + BATCH * NMOD + 1 * DM, modl + BATCH * NMOD + 0 * DM, gw, NGW, lane);
            else ln_pass<2>(args.out, args.out, nullptr, args.in[14] + (size_t)l * DM, args.in[15] + (size_t)l * DM, nullptr, nullptr, gw, NGW, lane); }
        if (l + 1 < DEPTH) GSYNC();
    }
}

extern "C" void kernel_launch(void* const* d_in, const int* in_sizes, int n_in, void* d_out, int out_size, void* d_ws, size_t ws_size, hipStream_t stream) {
    static int grid = 0;
    if (grid == 0) {
        if (n_in != 16 || out_size != T * DM || ws_size < WS_END) { fprintf(stderr, "kernel_launch: unexpected shapes (n_in %d, out %d, ws %zu < %zu)\n", n_in, out_size, ws_size, (size_t)WS_END); grid = -1; return; }
        int dev = 0, cus = 0, per_cu = 0;
        (void)hipGetDevice(&dev); (void)hipDeviceGetAttribute(&cus, hipDeviceAttributeMultiprocessorCount, dev);
        if (hipFuncSetAttribute((const void*)fwd_megakernel, hipFuncAttributeMaxDynamicSharedMemorySize, LDS_BYTES) != hipSuccess) { fprintf(stderr, "kernel_launch: hipFuncSetAttribute failed\n"); grid = -1; return; }
        if (hipOccupancyMaxActiveBlocksPerMultiprocessor(&per_cu, (const void*)fwd_megakernel, NTHR, LDS_BYTES) != hipSuccess || per_cu < 1) { fprintf(stderr, "kernel_launch: occupancy query says %d\n", per_cu); per_cu = 1; }
        (void)hipGetLastError();
        grid = cus * 1;
    }
    if (grid < 0) return;
    Args a{};
    for (int i = 0; i < 16; ++i) a.in[i] = (const float*)d_in[i];
    a.out = (float*)d_out; a.ws = (unsigned char*)d_ws;
    if (hipMemsetAsync((char*)d_ws + WS_BAR, 0, 16384, stream) != hipSuccess) { fprintf(stderr, "kernel_launch: hipMemsetAsync failed\n"); return; }
    void* kargs[] = {&a};
    hipError_t e = hipLaunchCooperativeKernel((const void*)fwd_megakernel, dim3(grid), dim3(NTHR), kargs, LDS_BYTES, stream);
    if (e != hipSuccess) fprintf(stderr, "kernel_launch: cooperative launch failed: %s (grid %d)\n", hipGetErrorString(e), grid);
}
```

```cpp
#define DBG_STAGE 0
#include <hip/hip_runtime.h>
#include <hip/hip_cooperative_groups.h>
#include <cstdio>
#include <cstdint>
namespace cg = cooperative_groups;

namespace pg8 {
#define PG8_LAS __attribute__((address_space(3)))
typedef unsigned short bf16_t;
typedef short bf16x8 __attribute__((ext_vector_type(8)));
typedef float f32x4 __attribute__((ext_vector_type(4)));
typedef unsigned u32x4 __attribute__((ext_vector_type(4)));
constexpr int BM = 256, BK = 64, HALF = 128, HTB = HALF * BK * 2  , STAGE_BYTES = 8 * HTB, NXCD = 8, WGM = 8;

__host__ __device__ __forceinline__ int lds_byte(int r, int c) { const int st = (r >> 4) * 2 + (c >> 5), rr = r & 15, cc = c & 31, ob = rr * 64 + cc * 2; return st * 1024 + (ob ^ (((ob >> 9) & 1) << 5)); }
__host__ __device__ __forceinline__ void stage_rc(int b, int& R, int& C) { const int st = b / 1024, sb = b % 1024, swz = sb ^ (((sb >> 9) & 1) << 5); R = (st >> 1) * 16 + swz / 64; C = (st & 1) * 32 + (swz % 64) / 2; }
__host__ __device__ __forceinline__ int perm32(int rho) { const int n = rho >> 4, i = rho & 15; return 8 * (i >> 2) + 4 * n + (i & 3); }

struct Unit { int pm, pn; };
struct Gemm { const bf16_t* A; const bf16_t* Bt; int M, N, K; int bshift; };

struct StaticOrder {
    int nM, nN, nwg, G, c;
    __host__ __device__ void init(int M, int N, int G_, int c_) { nM = M / BM; nN = N / BM; nwg = nM * nN; G = G_; c = c_; }
    __host__ __device__ bool next(int i, Unit& u) const {
        const long L = (long)i * G + c; if (L >= nwg) return false;
        int wgid = (int)L; { const int q = nwg / NXCD, r = nwg % NXCD, xcd = wgid % NXCD, off = wgid / NXCD; wgid = (xcd < r ? xcd * (q + 1) : r * (q + 1) + (xcd - r) * q) + off; }
        const int nig = WGM * nN, gid = wgid / nig, fm = gid * WGM, gsz = (nM - fm) < WGM ? (nM - fm) : WGM;
        u.pm = fm + ((wgid % nig) % gsz); u.pn = (wgid % nig) / gsz; return true;
    }
    __device__ __forceinline__ void a_ready(const Unit&) const {}
    __device__ __forceinline__ void done(const Unit&) const {}
};

__device__ __forceinline__ unsigned cvt_pk_bf16(float lo, float hi) { unsigned r; asm volatile("v_cvt_pk_bf16_f32 %0, %1, %2" : "=v"(r) : "v"(lo), "v"(hi)); return r; }
typedef float f32x2 __attribute__((ext_vector_type(2)));

template <class Epi, class Sched, bool ALIGN_EPI = false, bool SP2 = false>
__device__ __forceinline__ void gemm_phase(PG8_LAS unsigned char* lds, const Gemm g, const Sched& S, const Epi& E) {
    int tid_o = threadIdx.x; asm volatile("" : "+v"(tid_o));
    const int tid = tid_o, wid = __builtin_amdgcn_readfirstlane(tid >> 6), lane = tid & 63, wr = wid >> 2, wc = wid & 3, fr = lane & 15, fq = lane >> 4;
    const int K = g.K, nt = K / BK, bsh = g.bshift;
    unsigned voffA[2], voffB[2];
#pragma unroll
    for (int i = 0; i < 2; ++i) { int R, C; stage_rc(tid * 16 + i * 8192, R, C); int Rb = Epi::PERM ? ((R & ~31) + perm32(R & 31)) : R; if (bsh) { const int cnt = 256 >> bsh; Rb = ((Rb & (cnt - 1)) << bsh) + (Rb >> (8 - bsh)); }
        voffA[i] = (unsigned)(R * K + C) * 2u; voffB[i] = (unsigned)(Rb * K + C) * 2u; }
    const size_t kstep = (size_t)(BK * 2);
    const size_t hstep = (size_t)HALF * K * 2;
    const size_t hstepB = bsh ? ((size_t)(1 << (bsh - 1)) * K * 2) : hstep;
    const size_t tstep = 2 * hstep;
    const unsigned ldsw = (unsigned)wid * 1024u;
    const int aoff = lds_byte(wr * 64 + fr, fq * 8), boff = lds_byte(wc * 32 + fr, fq * 8);
#define PG8_SA(b, h) (((b) * 2 + (h)) * HTB)
#define PG8_SB(b, h) ((4 + (b) * 2 + (h)) * HTB)
#define PG8_STAGE(bufoff, gbase, voff) do { _Pragma("unroll") for (int _i = 0; _i < 2; ++_i) \
        __builtin_amdgcn_global_load_lds((const unsigned*)((const char*)(gbase) + (voff)[_i]), (PG8_LAS unsigned*)(lds + (bufoff) + ldsw + _i * 8192), 16, 0, 0); } while (0)
#define PG8_LDA(dst, b, h) do { _Pragma("unroll") for (int m = 0; m < 4; ++m) _Pragma("unroll") for (int k = 0; k < 2; ++k) dst[m][k] = *(const PG8_LAS bf16x8*)(lds + PG8_SA(b, h) + aoff + m * 2048 + k * 1024); } while (0)
#define PG8_LDB(dst, b, h) do { _Pragma("unroll") for (int n = 0; n < 2; ++n) _Pragma("unroll") for (int k = 0; k < 2; ++k) dst[n][k] = *(const PG8_LAS bf16x8*)(lds + PG8_SB(b, h) + boff + n * 2048 + k * 1024); } while (0)
#define PG8_MMA(ai, bj, At, Bt) do { __builtin_amdgcn_s_setprio(1); _Pragma("unroll") for (int m = 0; m < 4; ++m) _Pragma("unroll") for (int n = 0; n < 2; ++n) _Pragma("unroll") for (int k = 0; k < 2; ++k) \
        acc[ai][bj][m][n] = __builtin_amdgcn_mfma_f32_16x16x32_bf16(Bt[n][k], At[m][k], acc[ai][bj][m][n], 0, 0, 0); __builtin_amdgcn_s_setprio(0); } while (0)
#define PG8_WAIT_V(n) asm volatile("s_waitcnt vmcnt(" #n ")" ::: "memory")
#define PG8_WAIT_L(n) asm volatile("s_waitcnt lgkmcnt(" #n ")" ::: "memory")
#define PG8_BAR __builtin_amdgcn_s_barrier()
#define PG8_SCHED __builtin_amdgcn_sched_barrier(0)
    Unit cur, nxt; int ui = 0;
    if (!S.next(0, cur)) return;
    f32x4 acc[2][2][4][2];
#pragma unroll
    for (int a = 0; a < 2; ++a)
#pragma unroll
        for (int b = 0; b < 2; ++b)
#pragma unroll
            for (int m = 0; m < 4; ++m)
#pragma unroll
                for (int n = 0; n < 2; ++n) acc[a][b][m][n] = (f32x4){0.f, 0.f, 0.f, 0.f};
    bf16x8 At[4][2], B0[2][2], B1[2][2];
    const char* cA = (const char*)g.A + (size_t)cur.pm * tstep; const char* cB = (const char*)g.Bt + (size_t)cur.pn * tstep;
    S.a_ready(cur);
    if constexpr (SP2) {
        PG8_STAGE(PG8_SB(0, 0), cB, voffB); PG8_STAGE(PG8_SB(0, 1), cB + hstepB, voffB); PG8_STAGE(PG8_SA(0, 0), cA, voffA); PG8_STAGE(PG8_SA(0, 1), cA + hstep, voffA);
        if (wr == 1) PG8_BAR;
        PG8_WAIT_V(2); PG8_BAR;
        PG8_STAGE(PG8_SB(1, 0), cB + kstep, voffB); PG8_STAGE(PG8_SA(1, 0), cA + kstep, voffA); PG8_STAGE(PG8_SB(1, 1), cB + hstepB + kstep, voffB);
        PG8_WAIT_V(6); PG8_BAR;
    } else {
        PG8_STAGE(PG8_SB(0, 0), cB, voffB); PG8_STAGE(PG8_SA(0, 0), cA, voffA); PG8_STAGE(PG8_SB(0, 1), cB + hstepB, voffB); PG8_STAGE(PG8_SA(0, 1), cA + hstep, voffA);
        if (wr == 1) PG8_BAR;
        PG8_WAIT_V(4); PG8_BAR;
        PG8_STAGE(PG8_SB(1, 0), cB + kstep, voffB); PG8_STAGE(PG8_SA(1, 0), cA + kstep, voffA); PG8_STAGE(PG8_SB(1, 1), cB + hstepB + kstep, voffB);
        PG8_WAIT_V(6); PG8_BAR;
    }
    for (;;) {
        const bool has_next = S.next(ui + 1, nxt);
        const char* nA = has_next ? (const char*)g.A + (size_t)nxt.pm * tstep : cA; const char* nB = has_next ? (const char*)g.Bt + (size_t)nxt.pn * tstep : cB;
        for (int t = 0; t < nt; t += 2) {
            const bool last = (t == nt - 2);
            const char* a1 = cA + (size_t)(t + 1) * kstep;
            const char* a2 = last ? nA : cA + (size_t)(t + 2) * kstep; const char* b2 = last ? nB : cB + (size_t)(t + 2) * kstep;
            const char* a3 = a2 + kstep; const char* b3 = b2 + kstep;
            if (last && has_next) S.a_ready(nxt);
            if constexpr (SP2) {
            PG8_LDB(B0, 0, 0); PG8_LDB(B1, 0, 1); PG8_SCHED; PG8_LDA(At, 0, 0); PG8_STAGE(PG8_SA(1, 1), a1 + hstep, voffA);
            PG8_WAIT_V(8); PG8_WAIT_L(0); PG8_BAR; PG8_MMA(0, 0, At, B0); PG8_MMA(0, 1, At, B1); PG8_BAR; PG8_SCHED;
            PG8_LDA(At, 0, 1); PG8_STAGE(PG8_SB(0, 0), b2, voffB); PG8_STAGE(PG8_SB(0, 1), b2 + hstepB, voffB); PG8_STAGE(PG8_SA(0, 0), a2, voffA);
            PG8_WAIT_V(8); PG8_WAIT_L(0); PG8_BAR; PG8_MMA(1, 0, At, B0); PG8_MMA(1, 1, At, B1); PG8_BAR; PG8_SCHED;
            PG8_LDB(B0, 1, 0); PG8_LDB(B1, 1, 1); PG8_SCHED; PG8_LDA(At, 1, 0); PG8_STAGE(PG8_SA(0, 1), a2 + hstep, voffA);
            PG8_WAIT_V(8); PG8_WAIT_L(0); PG8_BAR; PG8_MMA(0, 0, At, B0); PG8_MMA(0, 1, At, B1); PG8_BAR; PG8_SCHED;
            PG8_LDA(At, 1, 1); PG8_STAGE(PG8_SB(1, 0), b3, voffB); PG8_STAGE(PG8_SB(1, 1), b3 + hstepB, voffB); PG8_STAGE(PG8_SA(1, 0), a3, voffA);
            PG8_WAIT_V(8); PG8_WAIT_L(0); PG8_BAR; PG8_MMA(1, 0, At, B0); PG8_MMA(1, 1, At, B1); PG8_BAR; PG8_SCHED;
            } else {
            PG8_LDB(B0, 0, 0); PG8_SCHED; PG8_LDA(At, 0, 0); PG8_STAGE(PG8_SA(1, 1), a1 + hstep, voffA);
            PG8_WAIT_L(8); PG8_BAR; PG8_WAIT_L(0); PG8_MMA(0, 0, At, B0); PG8_BAR; PG8_SCHED;
            PG8_LDB(B1, 0, 1); PG8_STAGE(PG8_SB(0, 0), b2, voffB);
            PG8_BAR; PG8_WAIT_L(0); PG8_MMA(0, 1, At, B1); PG8_BAR;
            PG8_LDA(At, 0, 1); PG8_STAGE(PG8_SA(0, 0), a2, voffA);
            PG8_BAR; PG8_WAIT_L(0); PG8_MMA(1, 0, At, B0); PG8_BAR; PG8_SCHED;
            PG8_STAGE(PG8_SB(0, 1), b2 + hstepB, voffB);
            PG8_WAIT_V(6); PG8_BAR; PG8_MMA(1, 1, At, B1); PG8_BAR;
            PG8_LDB(B0, 1, 0); PG8_SCHED; PG8_LDA(At, 1, 0); PG8_STAGE(PG8_SA(0, 1), a2 + hstep, voffA);
            PG8_WAIT_L(8); PG8_BAR; PG8_WAIT_L(0); PG8_MMA(0, 0, At, B0); PG8_BAR; PG8_SCHED;
            PG8_LDB(B1, 1, 1); PG8_STAGE(PG8_SB(1, 0), b3, voffB);
            PG8_BAR; PG8_WAIT_L(0); PG8_MMA(0, 1, At, B1); PG8_BAR;
            PG8_LDA(At, 1, 1); PG8_STAGE(PG8_SA(1, 0), a3, voffA);
            PG8_BAR; PG8_WAIT_L(0); PG8_MMA(1, 0, At, B0); PG8_BAR; PG8_SCHED;
            PG8_STAGE(PG8_SB(1, 1), b3 + hstepB, voffB);
            PG8_WAIT_V(6); PG8_BAR; PG8_MMA(1, 1, At, B1); PG8_BAR;
            }
        }
        if constexpr (ALIGN_EPI) { if (wr == 0) PG8_BAR; }
        if constexpr (!Epi::AFTER_DRAIN) { E(acc, cur, wr, wc, fr, fq); S.done(cur); }
        if (!has_next) break;
#pragma unroll
        for (int a = 0; a < 2; ++a)
#pragma unroll
            for (int b = 0; b < 2; ++b)
#pragma unroll
                for (int m = 0; m < 4; ++m)
#pragma unroll
                    for (int n = 0; n < 2; ++n) acc[a][b][m][n] = (f32x4){0.f, 0.f, 0.f, 0.f};
        cur = nxt; cA = nA; cB = nB; ++ui;
        if constexpr (ALIGN_EPI) { if (wr == 1) PG8_BAR; }
    }
    PG8_WAIT_V(0);
    if constexpr (!ALIGN_EPI) { if (wr == 0) PG8_BAR; }
    PG8_BAR;
    if constexpr (Epi::AFTER_DRAIN) { E.fused(acc, cur, wr, wc, fr, fq, lds, wid, lane); S.done(cur); }
#undef PG8_SA
#undef PG8_SB
#undef PG8_STAGE
#undef PG8_LDA
#undef PG8_LDB
#undef PG8_MMA
#undef PG8_WAIT_V
#undef PG8_WAIT_L
#undef PG8_BAR
#undef PG8_SCHED
}
}

constexpr int NWAVES = 8, NTHR = NWAVES * 64;
constexpr int BATCH = 4, SEQ = 8192, DM = 1024, DEPTH = 2, T = BATCH * SEQ;
constexpr int INW = 7168, DFF = 2816, NMOD = 6 * DM;
constexpr int NQKP = 3 * 1024 + 512;
constexpr float ALPHA = 1.41421356237309515f;
constexpr float LN_EPS = 1e-5f;
constexpr size_t MiB = 1u << 20;
constexpr size_t WS_MOD = 0;
constexpr size_t WS_BAR = 512 * 1024;
constexpr size_t WS_W = 1 * MiB;
constexpr size_t OW_QK = 0, OW_V = 7 * MiB, OW_G = 10 * MiB, OW_ATT = 14 * MiB, OW_PC = 15 * MiB, OW_O = 16 * MiB, OW_FI = 18 * MiB, OW_FO = 29 * MiB, LW = 34 * MiB + 512 * 1024;
constexpr size_t WS_H = WS_W + 2 * LW;
constexpr size_t WS_R2 = WS_H + 64 * MiB;
constexpr size_t WS_R3 = WS_R2 + 192 * MiB;
constexpr size_t WS_PIN = WS_R3 + 96 * MiB;
constexpr size_t WS_LSE = WS_PIN + 32 * MiB;
constexpr size_t WS_END = WS_LSE + 3 * MiB;
static_assert(WS_END <= 512 * MiB, "workspace map");
static_assert(OW_FO + (size_t)DM * DFF * 2 <= LW, "weight map");
constexpr int LDS_BYTES = 147456;

#define GAS __attribute__((address_space(1)))
#define LAS __attribute__((address_space(3)))
typedef unsigned short bf16;
typedef unsigned v4u __attribute__((ext_vector_type(4)));
typedef unsigned v2u __attribute__((ext_vector_type(2)));
typedef float f32x4 __attribute__((ext_vector_type(4)));
typedef float f32x16 __attribute__((ext_vector_type(16)));
typedef short bf16x8 __attribute__((ext_vector_type(8)));
typedef short s16x4 __attribute__((ext_vector_type(4)));
#define LDS_WAIT() asm volatile("s_waitcnt lgkmcnt(0)" ::: "memory")
__device__ __forceinline__ unsigned f2bf(float f) { unsigned u = __builtin_bit_cast(unsigned, f); return (u + 0x7fffu + ((u >> 16) & 1u)) >> 16; }
__device__ __forceinline__ unsigned pk2(float lo, float hi) { return f2bf(lo) | (f2bf(hi) << 16); }
__device__ __forceinline__ float bflo(unsigned w) { return __builtin_bit_cast(float, w << 16); }
__device__ __forceinline__ float bfhi(unsigned w) { return __builtin_bit_cast(float, w & 0xffff0000u); }
__device__ __forceinline__ float sigmoidf_(float x) { return __builtin_amdgcn_rcpf(1.0f + __expf(-x)); }
__device__ __forceinline__ float wave_sum(float v) {
#pragma unroll
    for (int o = 1; o < 64; o <<= 1) v += __shfl_xor(v, o);
    return v;
}
typedef __bf16 bf16x2_t __attribute__((ext_vector_type(2)));
typedef float f32x2_t __attribute__((ext_vector_type(2)));
__device__ __forceinline__ unsigned cvtpk(float lo, float hi) { f32x2_t v = {lo, hi}; bf16x2_t b = __builtin_convertvector(v, bf16x2_t); return __builtin_bit_cast(unsigned, b); }

typedef const f32x4 (&AccRef)[2][2][4][2];
#define CFENCE() asm volatile("" ::: "memory")

struct EpiQKP {
    static constexpr bool PERM = true, AFTER_DRAIN = false;
    bf16* QK; bf16* PIN;
    __device__ __forceinline__ void operator()(AccRef acc, const pg8::Unit& u, int wr, int wc, int fr, int fq) const {
        const int pn = u.pn; const bool isq = pn < 12;
        const int g = pn >> 2, sh = 2 * g, msk = (1 << sh) - 1, L = SEQ >> sh;
        bf16* base = isq ? QK + (size_t)g * T * 1024 + (pn & 3) * 256 : PIN + (pn - 12) * 256;
        const int pitch = isq ? 1024 : 512;
        const int col0 = wc * 32 + 8 * fq;
#pragma unroll
        for (int ai = 0; ai < 2; ++ai)
#pragma unroll
            for (int m = 0; m < 4; ++m) {
                const int r = u.pm * 256 + ai * 128 + wr * 64 + m * 16 + fr;
                unsigned prow = (unsigned)r;
                if (isq) { const int b = r >> 13, t = r & (SEQ - 1); prow = (unsigned)((b << 13) + (t & msk) * L + (t >> sh)); }
                const unsigned off = prow * (unsigned)pitch + (unsigned)col0;
#pragma unroll
                for (int bj = 0; bj < 2; ++bj) { const f32x4 v0 = acc[ai][bj][m][0], v1 = acc[ai][bj][m][1];
                    v4u w; w.x = cvtpk(v0[0], v0[1]); w.y = cvtpk(v0[2], v0[3]); w.z = cvtpk(v1[0], v1[1]); w.w = cvtpk(v1[2], v1[3]);
                    *(v4u*)(base + (off + bj * 128)) = w; }
                CFENCE(); }
    }
};
struct EpiVT {
    static constexpr bool PERM = true, AFTER_DRAIN = false;
    bf16* VTg; int sh;
    __device__ __forceinline__ void operator()(AccRef acc, const pg8::Unit& u, int wr, int wc, int fr, int fq) const {
        const int pn = u.pn, b = pn >> 5, tb = (pn & 31) * 256, L = SEQ >> sh, cntm = (256 >> sh) - 1;
#pragma unroll
        for (int ai = 0; ai < 2; ++ai)
#pragma unroll
            for (int m = 0; m < 4; ++m) {
                const int r = u.pm * 256 + ai * 128 + wr * 64 + m * 16 + fr;
                const unsigned roff = (unsigned)r * (unsigned)T + (unsigned)(b * SEQ + (tb >> sh));
#pragma unroll
                for (int bj = 0; bj < 2; ++bj) { const int s = bj * 128 + wc * 32 + 8 * fq, p = s >> (8 - sh), i = s & cntm;
                    const f32x4 v0 = acc[ai][bj][m][0], v1 = acc[ai][bj][m][1];
                    v4u w; w.x = cvtpk(v0[0], v0[1]); w.y = cvtpk(v0[2], v0[3]); w.z = cvtpk(v1[0], v1[1]); w.w = cvtpk(v1[2], v1[3]);
                    *(v4u*)(VTg + (roff + (unsigned)(p * L + i))) = w; }
                CFENCE(); }
    }
};
struct EpiSig {
    static constexpr bool PERM = true, AFTER_DRAIN = false;
    bf16* SG;
    __device__ __forceinline__ void operator()(AccRef acc, const pg8::Unit& u, int wr, int wc, int fr, int fq) const {
        const int col0 = u.pn * 256 + wc * 32 + 8 * fq;
#pragma unroll
        for (int ai = 0; ai < 2; ++ai)
#pragma unroll
            for (int m = 0; m < 4; ++m) {
                const int r = u.pm * 256 + ai * 128 + wr * 64 + m * 16 + fr;
                const unsigned off = (unsigned)r * 2048u + (unsigned)col0;
#pragma unroll
                for (int bj = 0; bj < 2; ++bj) { const f32x4 v0 = acc[ai][bj][m][0], v1 = acc[ai][bj][m][1];
                    v4u w; w.x = cvtpk(sigmoidf_(v0[0]), sigmoidf_(v0[1])); w.y = cvtpk(sigmoidf_(v0[2]), sigmoidf_(v0[3]));
                    w.z = cvtpk(sigmoidf_(v1[0]), sigmoidf_(v1[1])); w.w = cvtpk(sigmoidf_(v1[2]), sigmoidf_(v1[3]));
                    *(v4u*)(SG + (off + bj * 128)) = w; }
                CFENCE(); }
    }
};
template <bool ACCUM> struct EpiMerge {
    static constexpr bool PERM = true, AFTER_DRAIN = false;
    const bf16* SG; bf16* MG; int goff;
    __device__ __forceinline__ void operator()(AccRef acc, const pg8::Unit& u, int wr, int wc, int fr, int fq) const {
        const int col0 = u.pn * 256 + wc * 32 + 8 * fq;
#pragma unroll
        for (int ai = 0; ai < 2; ++ai)
#pragma unroll
            for (int m = 0; m < 4; ++m) {
                const int r = u.pm * 256 + ai * 128 + wr * 64 + m * 16 + fr;
                const unsigned so = (unsigned)r * 2048u + (unsigned)(goff + col0), mo = (unsigned)r * 1024u + (unsigned)col0;
#pragma unroll
                for (int bj = 0; bj < 2; ++bj) { const f32x4 v0 = acc[ai][bj][m][0], v1 = acc[ai][bj][m][1];
                    const v4u s = *(const v4u*)(SG + (so + bj * 128));
                    float o0 = bflo(s.x) * v0[0], o1 = bfhi(s.x) * v0[1], o2 = bflo(s.y) * v0[2], o3 = bfhi(s.y) * v0[3];
                    float o4 = bflo(s.z) * v1[0], o5 = bfhi(s.z) * v1[1], o6 = bflo(s.w) * v1[2], o7 = bfhi(s.w) * v1[3];
                    if (ACCUM) { const v4u q = *(const v4u*)(MG + (mo + bj * 128));
                        o0 += bflo(q.x); o1 += bfhi(q.x); o2 += bflo(q.y); o3 += bfhi(q.y); o4 += bflo(q.z); o5 += bfhi(q.z); o6 += bflo(q.w); o7 += bfhi(q.w); }
                    v4u w; w.x = cvtpk(o0, o1); w.y = cvtpk(o2, o3); w.z = cvtpk(o4, o5); w.w = cvtpk(o6, o7);
                    *(v4u*)(MG + (mo + bj * 128)) = w; }
                CFENCE(); }
    }
};
struct EpiRes {
    static constexpr bool PERM = false, AFTER_DRAIN = false;
    const float* xin; float* XB; const float* gate;
    __device__ __forceinline__ void operator()(AccRef acc, const pg8::Unit& u, int wr, int wc, int fr, int fq) const {
        const int col0 = u.pn * 256 + wc * 32 + 4 * fq; const int b = u.pm >> 5;
        f32x4 gv[2][2];
#pragma unroll
        for (int bj = 0; bj < 2; ++bj)
#pragma unroll
            for (int n = 0; n < 2; ++n) gv[bj][n] = *(const f32x4*)(gate + (unsigned)(b * NMOD + col0 + bj * 128 + n * 16)) + 1.0f;
#pragma unroll
        for (int ai = 0; ai < 2; ++ai)
#pragma unroll
            for (int m = 0; m < 4; ++m) {
                const int r = u.pm * 256 + ai * 128 + wr * 64 + m * 16 + fr; const unsigned off = (unsigned)r * (unsigned)DM + (unsigned)col0;
#pragma unroll
                for (int bj = 0; bj < 2; ++bj)
#pragma unroll
                    for (int n = 0; n < 2; ++n) { const f32x4 xv = *(const f32x4*)(xin + off + bj * 128 + n * 16);
                        *(f32x4*)(XB + off + bj * 128 + n * 16) = xv * ALPHA + gv[bj][n] * acc[ai][bj][m][n]; }
                CFENCE(); }
    }
};
struct EpiSwiGLU {
    static constexpr bool PERM = true, AFTER_DRAIN = false;
    bf16* HID;
    __device__ __forceinline__ void operator()(AccRef acc, const pg8::Unit& u, int wr, int wc, int fr, int fq) const {
        const int col0 = u.pn * 128 + wc * 32 + 8 * fq;
#pragma unroll
        for (int ai = 0; ai < 2; ++ai)
#pragma unroll
            for (int m = 0; m < 4; ++m) {
                const int r = u.pm * 256 + ai * 128 + wr * 64 + m * 16 + fr;
                float o[8];
#pragma unroll
                for (int n = 0; n < 2; ++n)
#pragma unroll
                    for (int e = 0; e < 4; ++e) { const float a = acc[ai][0][m][n][e], bb = acc[ai][1][m][n][e]; o[4 * n + e] = a * sigmoidf_(a) * bb; }
                v4u w; w.x = cvtpk(o[0], o[1]); w.y = cvtpk(o[2], o[3]); w.z = cvtpk(o[4], o[5]); w.w = cvtpk(o[6], o[7]);
                *(v4u*)(HID + ((unsigned)r * (unsigned)DFF + (unsigned)col0)) = w; CFENCE(); }
    }
};

template <int MAP> __device__ __forceinline__ int srccol(int n) {
    if (MAP == 1) { return n < 3072 ? (n >> 10) * 1536 + (n & 1023) : 4608 + (n - 3072); }
    if (MAP == 2) { return (n >> 9) * 1536 + 1024 + (n & 511); }
    if (MAP == 3) { return 5120 + n; }
    if (MAP == 4) { return ((n >> 7) & 1) * DFF + (n >> 8) * 128 + (n & 127); }
    return n;
}
template <int MAP> __device__ __forceinline__ void transpose_mat(const float* W, int K, int Nsrc, bf16* WT, int Ndst, LAS float* scr, int gw, int NGW, int lane) {
    const int nblk = Ndst / 32, nitems = (K / 64) * nblk;
    for (int item = gw; item < nitems; item += NGW) {
        const int kb = item / nblk, nb = item % nblk, k0 = 64 * kb, n0 = 32 * nb, s0 = srccol<MAP>(n0);
#pragma unroll 8
        for (int i = 0; i < 32; ++i) { const int kk = 2 * i + (lane >> 5); scr[kk * 33 + (lane & 31)] = W[(size_t)(k0 + kk) * Nsrc + s0 + (lane & 31)]; }
        LDS_WAIT(); asm volatile("" ::: "memory");
        const int c = lane & 7;
#pragma unroll
        for (int j = 0; j < 4; ++j) { const int n = (lane >> 3) + 8 * j; const LAS float* s = scr + (8 * c) * 33 + n;
            v4u o; o.x = pk2(s[0 * 33], s[1 * 33]); o.y = pk2(s[2 * 33], s[3 * 33]); o.z = pk2(s[4 * 33], s[5 * 33]); o.w = pk2(s[6 * 33], s[7 * 33]);
            *(v4u*)(WT + (size_t)(n0 + n) * K + k0 + 8 * c) = o; }
        LDS_WAIT(); asm volatile("" ::: "memory");
    }
}
struct Args { const float* in[16]; float* out; unsigned char* ws; };

__device__ __forceinline__ void p0_prologue(const Args& A, LAS unsigned char* lds, int tid, int lane, int wave, int G) {
    LAS float* scr = (LAS float*)(lds + wave * 16384);
    const int gw = blockIdx.x * NWAVES + wave, NGW = G * NWAVES;
    for (int l = 0; l < DEPTH; ++l) {
        unsigned char* wl = A.ws + WS_W + (size_t)l * LW;
        const float* w_in = A.in[4] + (size_t)l * DM * INW;
        transpose_mat<1>(w_in, DM, INW, (bf16*)(wl + OW_QK), NQKP, scr, gw, NGW, lane);
        transpose_mat<2>(w_in, DM, INW, (bf16*)(wl + OW_V), 1536, scr, gw, NGW, lane);
        transpose_mat<3>(w_in, DM, INW, (bf16*)(wl + OW_G), 2048, scr, gw, NGW, lane);
        transpose_mat<0>(A.in[7] + (size_t)l * 512 * DM, 512, DM, (bf16*)(wl + OW_ATT), DM, scr, gw, NGW, lane);
        transpose_mat<0>(A.in[9] + (size_t)l * DM * DM, DM, DM, (bf16*)(wl + OW_O), DM, scr, gw, NGW, lane);
        transpose_mat<4>(A.in[12] + (size_t)l * DM * 2 * DFF, DM, 2 * DFF, (bf16*)(wl + OW_FI), 2 * DFF, scr, gw, NGW, lane);
        transpose_mat<0>(A.in[13] + (size_t)l * DFF * DM, DFF, DM, (bf16*)(wl + OW_FO), DM, scr, gw, NGW, lane);
        const float* mix = A.in[5] + (size_t)l * 4 * 128 * 128; const float* psc = A.in[6] + (size_t)l * 512; const float* wpo = A.in[8] + (size_t)l * 512 * DM;
        bf16* wpc = (bf16*)(wl + OW_PC);
        for (int o = (blockIdx.x * NTHR + tid); o < 128 * DM; o += G * NTHR) {
            const int n = o & 1023, k4 = (o >> 10) * 4, gg = k4 >> 7; float a0 = 0.f, a1 = 0.f, a2 = 0.f, a3 = 0.f;
            const float* mr = mix + (size_t)gg * 128 * 128 + (size_t)(k4 & 127) * 128;
            for (int j = 0; j < 128; ++j) { const float wv = psc[gg * 128 + j] * wpo[(size_t)(gg * 128 + j) * DM + n];
                a0 += mr[j] * wv; a1 += mr[128 + j] * wv; a2 += mr[256 + j] * wv; a3 += mr[384 + j] * wv; }
            v2u w; w.x = pk2(a0, a1); w.y = pk2(a2, a3); *(v2u*)(wpc + (size_t)n * 512 + k4) = w;
        }
    }
    __syncthreads();
    {
        LAS float* red = (LAS float*)lds;
        const float* c = A.in[1]; float* MOD = (float*)(A.ws + WS_MOD);
        const int ks = tid >> 6, col = tid & 63;
        for (int item = blockIdx.x; item < DEPTH * NMOD / 64; item += G) {
            const int l = item / (NMOD / 64), n = (item % (NMOD / 64)) * 64 + col;
            const float* w = A.in[2] + (size_t)l * DM * NMOD + n;
            float a0 = 0.f, a1 = 0.f, a2 = 0.f, a3 = 0.f;
            for (int k = ks * 128; k < ks * 128 + 128; ++k) { const float wv = w[(size_t)k * NMOD];
                const float c0 = c[k], c1 = c[DM + k], c2 = c[2 * DM + k], c3 = c[3 * DM + k];
                a0 += c0 * sigmoidf_(c0) * wv; a1 += c1 * sigmoidf_(c1) * wv; a2 += c2 * sigmoidf_(c2) * wv; a3 += c3 * sigmoidf_(c3) * wv; }
            red[(ks * 4 + 0) * 64 + col] = a0; red[(ks * 4 + 1) * 64 + col] = a1; red[(ks * 4 + 2) * 64 + col] = a2; red[(ks * 4 + 3) * 64 + col] = a3;
            __syncthreads();
            if (tid < 256) { const int b = tid >> 6; float s = 0.f;
#pragma unroll
                for (int q = 0; q < 8; ++q) s += red[(q * 4 + b) * 64 + col];
                MOD[((size_t)l * BATCH + b) * NMOD + n] = s + A.in[3][(size_t)l * NMOD + n]; }
            __syncthreads();
        }
    }
}

template <int MODE> __device__ __forceinline__ void ln_pass(const float* in, float* out, bf16* H, const float* lg, const float* lb, const float* sc, const float* sh, int gw, int NGW, int lane_) {
    int lane = lane_; asm volatile("" : "+v"(lane));
    for (int row = gw; row < T; row += NGW) {
        const int b = row >> 13;
        const f32x4* xr = (const f32x4*)(in + (size_t)row * DM) + lane;
        f32x4 v[4]; float s = 0.f;
#pragma unroll
        for (int j = 0; j < 4; ++j) { v[j] = xr[64 * j]; s += (v[j].x + v[j].y) + (v[j].z + v[j].w); }
        float mean = wave_sum(s) * (1.f / DM), s2 = 0.f;
#pragma unroll
        for (int j = 0; j < 4; ++j) { v[j] = v[j] - mean; s2 += (v[j].x * v[j].x + v[j].y * v[j].y) + (v[j].z * v[j].z + v[j].w * v[j].w); }
        float rstd = 1.f / sqrtf(wave_sum(s2) * (1.f / DM) + LN_EPS);
        if (MODE != 0) {
            f32x4* orow = (f32x4*)(out + (size_t)row * DM) + lane; s = 0.f;
#pragma unroll
            for (int j = 0; j < 4; ++j) { const f32x4 gg = ((const f32x4*)lg)[lane + 64 * j], bb = ((const f32x4*)lb)[lane + 64 * j];
                v[j] = v[j] * rstd * gg + bb; orow[64 * j] = v[j]; s += (v[j].x + v[j].y) + (v[j].z + v[j].w); }
            if (MODE == 2) continue;
            mean = wave_sum(s) * (1.f / DM); s2 = 0.f;
#pragma unroll
            for (int j = 0; j < 4; ++j) { v[j] = v[j] - mean; s2 += (v[j].x * v[j].x + v[j].y * v[j].y) + (v[j].z * v[j].z + v[j].w * v[j].w); }
            rstd = 1.f / sqrtf(wave_sum(s2) * (1.f / DM) + LN_EPS);
        }
        v2u* hrow = (v2u*)(H + (size_t)row * DM) + lane;
#pragma unroll
        for (int j = 0; j < 4; ++j) { const f32x4 a = ((const f32x4*)(sc + (size_t)b * NMOD))[lane + 64 * j] + 1.0f, d = ((const f32x4*)(sh + (size_t)b * NMOD))[lane + 64 * j];
            const f32x4 h = v[j] * rstd * a + d; v2u w; w.x = pk2(h.x, h.y); w.y = pk2(h.z, h.w); hrow[64 * j] = w; }
    }
}

#define MFMA32(a, b, c) __builtin_amdgcn_mfma_f32_32x32x16_bf16((a), (b), (c), 0, 0, 0)
constexpr int KPITCH = 144, VPITCH = 776, ATT_VOFF = 384 * KPITCH;
__device__ __forceinline__ void attn_wg_unit(LAS unsigned char* lds, bf16* QKg, const bf16* VTg, float* LSEg, int b, int h, int p, int qblk, int sh, float sr, int tid_, int wave) {
    int tid = tid_; asm volatile("" : "+v"(tid));
    const int lane = tid & 63, L = SEQ >> sh, a = lane & 31, hi = lane >> 5, Q0 = qblk * 256, q0 = Q0 + 32 * wave, klo = Q0 - 64;
    const unsigned rowbase = (unsigned)(b * SEQ + p * L);
    v4u kreg[6], vreg[6];
#pragma unroll
    for (int i = 0; i < 6; ++i) { const int c = tid + 512 * i, row = c >> 3, piece = c & 7, key = klo + row;
        kreg[i] = (v4u){0u, 0u, 0u, 0u};
        if (key >= 0 && key < L) kreg[i] = *(const v4u*)(QKg + ((rowbase + (unsigned)key) * 1024u + (unsigned)(512 + h * 64 + piece * 8))); }
#pragma unroll
    for (int i = 0; i < 6; ++i) { const int c = tid + 512 * i, d = c / 48, piece = c - d * 48, key = klo + piece * 8;
        vreg[i] = (v4u){0u, 0u, 0u, 0u};
        if (key >= 0 && key < L) vreg[i] = *(const v4u*)(VTg + ((unsigned)(h * 64 + d) * (unsigned)T + rowbase + (unsigned)key)); }
    const unsigned qoff = (rowbase + (unsigned)(q0 + a)) * 1024u + (unsigned)(h * 64);
    bf16x8 qf[4];
#pragma unroll
    for (int s = 0; s < 4; ++s) qf[s] = *(const bf16x8*)(QKg + (qoff + (unsigned)(16 * s + 8 * hi)));
#pragma unroll
    for (int i = 0; i < 6; ++i) { const int c = tid + 512 * i, row = c >> 3, piece = c & 7; *(LAS v4u*)(lds + row * KPITCH + piece * 16) = kreg[i]; }
#pragma unroll
    for (int i = 0; i < 6; ++i) { const int c = tid + 512 * i, d = c / 48, piece = c - d * 48; LAS v2u* dst = (LAS v2u*)(lds + ATT_VOFF + d * VPITCH + piece * 16);
        dst[0] = (v2u){vreg[i].x, vreg[i].y}; dst[1] = (v2u){vreg[i].z, vreg[i].w}; }
    __syncthreads();
    f32x16 st[5];
    float mx = -1e30f;
    const LAS unsigned char* kl = lds + (32 * wave + a) * KPITCH + 16 * hi;
#pragma unroll
    for (int j = 0; j < 5; ++j) {
        const int kt0 = q0 - 64 + 32 * j; const bool inr = (kt0 >= 0) && (kt0 < L);
        f32x16 acc;
#pragma unroll
        for (int e = 0; e < 16; ++e) acc[e] = 0.f;
        if (inr) {
            bf16x8 kf[4];
#pragma unroll
            for (int s = 0; s < 4; ++s) kf[s] = *(const LAS bf16x8*)(kl + 32 * j * KPITCH + 32 * s);
#pragma unroll
            for (int s = 0; s < 4; ++s) acc = MFMA32(kf[s], qf[s], acc);
        }
#pragma unroll
        for (int e = 0; e < 16; ++e) {
            const int c = (e & 3) + 8 * (e >> 2) + 4 * hi, rel = 32 * j - 64 + c - a, ar = rel < 0 ? -rel : rel;
            float v = acc[e] * 0.125f - sr * (float)ar;
            if (j == 0) v += fminf((float)(c - a), 0.f) * 1e30f;
            if (j == 4) v += fminf((float)(a - c), 0.f) * 1e30f;
            if (!inr) v = -1e30f;
            acc[e] = v; mx = fmaxf(mx, v);
        }
        st[j] = acc;
    }
    mx = fmaxf(mx, __shfl_xor(mx, 32));
    float lsum = 0.f;
#pragma unroll
    for (int j = 0; j < 5; ++j)
#pragma unroll
        for (int e = 0; e < 16; ++e) { const float pv = __expf(st[j][e] - mx); st[j][e] = pv; lsum += pv; }
    lsum += __shfl_xor(lsum, 32);
    f32x16 o0, o1;
#pragma unroll
    for (int e = 0; e < 16; ++e) { o0[e] = 0.f; o1[e] = 0.f; }
    const LAS unsigned char* vl = lds + ATT_VOFF + a * VPITCH + (32 * wave + 4 * hi) * 2;
#pragma unroll
    for (int j = 0; j < 5; ++j) {
        const int kt0 = q0 - 64 + 32 * j; const bool inr = (kt0 >= 0) && (kt0 < L);
        if (inr) {
#pragma unroll
            for (int s2 = 0; s2 < 2; ++s2) {
                v4u pw; pw.x = cvtpk(st[j][8 * s2 + 0], st[j][8 * s2 + 1]); pw.y = cvtpk(st[j][8 * s2 + 2], st[j][8 * s2 + 3]);
                pw.z = cvtpk(st[j][8 * s2 + 4], st[j][8 * s2 + 5]); pw.w = cvtpk(st[j][8 * s2 + 6], st[j][8 * s2 + 7]);
                const bf16x8 pf = __builtin_bit_cast(bf16x8, pw);
                const LAS unsigned char* vp = vl + (32 * j + 16 * s2) * 2;
                v4u va, vb;
                { const v2u x0 = *(const LAS v2u*)(vp), x1 = *(const LAS v2u*)(vp + 16); va.x = x0.x; va.y = x0.y; va.z = x1.x; va.w = x1.y; }
                { const v2u x0 = *(const LAS v2u*)(vp + 32 * VPITCH), x1 = *(const LAS v2u*)(vp + 32 * VPITCH + 16); vb.x = x0.x; vb.y = x0.y; vb.z = x1.x; vb.w = x1.y; }
                o0 = MFMA32(__builtin_bit_cast(bf16x8, va), pf, o0);
                o1 = MFMA32(__builtin_bit_cast(bf16x8, vb), pf, o1);
            }
        }
    }
    const float inv = 1.0f / lsum;
#pragma unroll
    for (int gq = 0; gq < 4; ++gq) {
        v2u w0, w1;
        w0.x = cvtpk(o0[4 * gq] * inv, o0[4 * gq + 1] * inv); w0.y = cvtpk(o0[4 * gq + 2] * inv, o0[4 * gq + 3] * inv);
        w1.x = cvtpk(o1[4 * gq] * inv, o1[4 * gq + 1] * inv); w1.y = cvtpk(o1[4 * gq + 2] * inv, o1[4 * gq + 3] * inv);
        *(v2u*)(QKg + (qoff + (unsigned)(8 * gq + 4 * hi))) = w0; *(v2u*)(QKg + (qoff + (unsigned)(32 + 8 * gq + 4 * hi))) = w1;
    }
    if (hi == 0) LSEg[((unsigned)(b * SEQ + p) + ((unsigned)(q0 + a) << sh)) * 8u + (unsigned)h] = mx + __logf(lsum);
    __syncthreads();
}
__device__ __forceinline__ void attn_phase(LAS unsigned char* lds, bf16* QK, const bf16* VT, float* LSE, int G, int tid, int wave) {
    constexpr int NU = 3 * BATCH * 8 * 32;
    for (int u = blockIdx.x; u < NU; u += G) {
        const int pq = u & 31, h = (u >> 5) & 7, b = (u >> 8) & 3, g = u >> 10, sh = 2 * g, L256 = (SEQ >> sh) >> 8;
        const int p = pq / L256, qblk = pq % L256;
        const float slope = exp2f(-8.0f * (float)(g * 8 + h + 1) / 24.0f);
        attn_wg_unit(lds, QK + (size_t)g * T * 1024, VT + (size_t)g * 512 * T, LSE + (size_t)g * T * 8, b, h, p, qblk, sh, slope * (float)(1 << sh), tid, wave);
    }
}

__device__ __forceinline__ void combine_pool_phase(const bf16* QK, const float* LSE, const bf16* PIN, bf16* ATT, bf16* POOLED, int gw, int NGW, int lane_) {
    int lane = lane_; asm volatile("" : "+v"(lane));
    for (int tok = gw; tok < T; tok += NGW) {
        const int b = tok >> 13, t = tok & (SEQ - 1);
        {
            const int hh = lane >> 3, d0 = (lane & 7) * 8;
            const float l0 = LSE[((size_t)0 * T + tok) * 8 + hh], l1 = LSE[((size_t)1 * T + tok) * 8 + hh], l2 = LSE[((size_t)2 * T + tok) * 8 + hh];
            const float m = fmaxf(l0, fmaxf(l1, l2)); float w0 = __expf(l0 - m), w1 = __expf(l1 - m), w2 = __expf(l2 - m);
            const float inv = 1.0f / (w0 + w1 + w2); w0 *= inv; w1 *= inv; w2 *= inv;
            const size_t r0 = (size_t)tok, r1 = ((size_t)b << 13) + (size_t)(t & 3) * (SEQ / 4) + (t >> 2), r2 = ((size_t)b << 13) + (size_t)(t & 15) * (SEQ / 16) + (t >> 4);
            const v4u a0 = *(const v4u*)(QK + r0 * 1024 + hh * 64 + d0), a1 = *(const v4u*)(QK + ((size_t)T + r1) * 1024 + hh * 64 + d0), a2 = *(const v4u*)(QK + ((size_t)2 * T + r2) * 1024 + hh * 64 + d0);
            v4u w;
            w.x = pk2(w0 * bflo(a0.x) + w1 * bflo(a1.x) + w2 * bflo(a2.x), w0 * bfhi(a0.x) + w1 * bfhi(a1.x) + w2 * bfhi(a2.x));
            w.y = pk2(w0 * bflo(a0.y) + w1 * bflo(a1.y) + w2 * bflo(a2.y), w0 * bfhi(a0.y) + w1 * bfhi(a1.y) + w2 * bfhi(a2.y));
            w.z = pk2(w0 * bflo(a0.z) + w1 * bflo(a1.z) + w2 * bflo(a2.z), w0 * bfhi(a0.z) + w1 * bfhi(a1.z) + w2 * bfhi(a2.z));
            w.w = pk2(w0 * bflo(a0.w) + w1 * bflo(a1.w) + w2 * bflo(a2.w), w0 * bfhi(a0.w) + w1 * bfhi(a1.w) + w2 * bfhi(a2.w));
            *(v4u*)(ATT + (size_t)tok * 512 + hh * 64 + d0) = w;
        }
        {
            const int half = 1 << (lane >> 4), lo = (t - half) < 0 ? 0 : (t - half), hi = (t + half) > SEQ ? SEQ : (t + half);
            const bf16* base = PIN + ((size_t)b << 13) * 512 + lane * 8;
            float s[8];
#pragma unroll
            for (int e = 0; e < 8; ++e) s[e] = 0.f;
            for (int tt = lo; tt < hi; ++tt) { const v4u x = *(const v4u*)(base + (size_t)tt * 512);
                s[0] += bflo(x.x); s[1] += bfhi(x.x); s[2] += bflo(x.y); s[3] += bfhi(x.y); s[4] += bflo(x.z); s[5] += bfhi(x.z); s[6] += bflo(x.w); s[7] += bfhi(x.w); }
            const float rc = 1.0f / (float)(hi - lo); const v4u x = *(const v4u*)(base + (size_t)t * 512);
            v4u w; w.x = pk2(s[0] * rc - bflo(x.x), s[1] * rc - bfhi(x.x)); w.y = pk2(s[2] * rc - bflo(x.y), s[3] * rc - bfhi(x.y));
            w.z = pk2(s[4] * rc - bflo(x.z), s[5] * rc - bfhi(x.z)); w.w = pk2(s[6] * rc - bflo(x.w), s[7] * rc - bfhi(x.w));
            *(v4u*)(POOLED + (size_t)tok * 512 + lane * 8) = w;
        }
    }
}

#define XB_TMO      128
#define XB_XCNT(j)  (256  + 64 * (j))
#define XB_XSUB(j)  (1280 + 64 * (j))
#define XB_XGEN(j)  (2304 + 64 * (j))
#define XB_TOP      3328
#define XB_TOPGEN   3392
#define XCD_BAR_WORDS 3456
#define XB_SPIN_CAP (1u << 18)

__device__ __forceinline__ unsigned xb_ld(unsigned* p)              { return __hip_atomic_load(p, __ATOMIC_RELAXED, __HIP_MEMORY_SCOPE_AGENT); }
__device__ __forceinline__ unsigned xb_add(unsigned* p, unsigned v) { return __hip_atomic_fetch_add(p, v, __ATOMIC_RELAXED, __HIP_MEMORY_SCOPE_AGENT); }
__device__ __forceinline__ unsigned xb_xcc_id() { return (unsigned)__builtin_amdgcn_s_getreg((3 << 11) | 20) & 0xFu; }
#define XB_SPIN(cond, bar) do { unsigned _sp = 0; while (cond) { __builtin_amdgcn_s_sleep(1); \
    if ((++_sp & 255u) == 0u) { if (xb_ld(&(bar)[XB_TMO])) break; if (_sp > XB_SPIN_CAP) { atomicAdd(&(bar)[XB_TMO], 1u); break; } } } } while (0)

struct XcdBarrier {
    unsigned* bar; unsigned x;
    volatile LAS unsigned* st;
};

__device__ __forceinline__ XcdBarrier xcd_barrier_post(unsigned* bar, volatile LAS unsigned* st) {
    XcdBarrier b; b.bar = bar; b.x = xb_xcc_id(); b.st = st;
    if (threadIdx.x == 0) (void)xb_add(&bar[XB_XCNT(b.x)], 1u);
    return b;
}
__device__ __forceinline__ void xcd_barrier_complete(unsigned* bar, unsigned x, unsigned& nloc, unsigned& nx) {
    const unsigned G = gridDim.x * gridDim.y * gridDim.z;
    unsigned sum, cnt, mine, sp = 0u;
    for (;;) {
        sum = 0u; cnt = 0u; mine = 0u;
#pragma unroll
        for (unsigned j = 0; j < 16; ++j) { const unsigned c = xb_ld(&bar[XB_XCNT(j)]); sum += c; cnt += (c > 0u) ? 1u : 0u; mine = (j == x) ? c : mine; }
        if (sum == G) break;
        __builtin_amdgcn_s_sleep(1);
        if ((++sp & 255u) == 0u) { if (xb_ld(&bar[XB_TMO])) break; if (sp > XB_SPIN_CAP) { atomicAdd(&bar[XB_TMO], 1u); break; } }
    }
    nloc = mine > 0u ? mine : 1u; nx = cnt > 0u ? cnt : 1u;
}

__device__ __forceinline__ void xcd_barrier(const XcdBarrier& b) {
    asm volatile("s_waitcnt vmcnt(0)" ::: "memory");
    __syncthreads();
    if (threadIdx.x == 0) {
        unsigned* bar = b.bar;
        __builtin_amdgcn_s_waitcnt(0);
        unsigned nloc = b.st[0], nx = b.st[1];
        if (nloc == 0u) { xcd_barrier_complete(bar, b.x, nloc, nx); b.st[0] = nloc; b.st[1] = nx; }
        const unsigned old = xb_add(&bar[XB_XSUB(b.x)], 1u);
        const unsigned gen = old / nloc;
        if (old + 1u == (gen + 1u) * nloc) {
            __builtin_amdgcn_fence(__ATOMIC_RELEASE, "agent");
            asm volatile("s_waitcnt vmcnt(0)" ::: "memory");
            const unsigned og = xb_add(&bar[XB_TOP], 1u);
            const unsigned tg = og / nx;
            if (og + 1u == (tg + 1u) * nx) xb_add(&bar[XB_TOPGEN], 1u);
            else XB_SPIN(xb_ld(&bar[XB_TOPGEN]) == tg, bar);
            __builtin_amdgcn_fence(__ATOMIC_ACQUIRE, "agent");
            xb_add(&bar[XB_XGEN(b.x)], 1u);
            asm volatile("s_waitcnt vmcnt(0)" ::: "memory");
        } else {
            XB_SPIN(xb_ld(&bar[XB_XGEN(b.x)]) == gen, bar);
            __builtin_amdgcn_fence(__ATOMIC_ACQUIRE, "agent");
            asm volatile("s_waitcnt vmcnt(0)" ::: "memory");
        }
    }
    __syncthreads();
}

#ifndef DBG_STAGE
#define DBG_STAGE 0
#endif
__device__ __forceinline__ void dbg_dump(float* out, const bf16* src, int pitch, int ncols, int coloff, int tid, int G) {
    const size_t n = (size_t)T * ncols;
    for (size_t i = (size_t)blockIdx.x * NTHR + tid; i < n; i += (size_t)G * NTHR) { const size_t r = i / ncols, c = i % ncols; out[r * 1024 + coloff + c] = bflo((unsigned)src[r * pitch + c]); }
}
#define DBG(n, stmt) do { if (DBG_STAGE == (n) && l == 0) { GSYNC(); stmt; return; } } while (0)
template <class Epi> __device__ __forceinline__ void run_gemm(LAS unsigned char* lds, const bf16* A, const bf16* Bt, int M, int N, int K, int bshift, int G, const Epi& E) {
    pg8::Gemm g{A, Bt, M, N, K, bshift}; pg8::StaticOrder S; S.init(M, N, G, (int)blockIdx.x);
    pg8::gemm_phase<Epi, pg8::StaticOrder, true, true>(lds, g, S, E);
}

__global__ void __launch_bounds__(NTHR, 2) fwd_megakernel(Args args) {
    extern __shared__ __attribute__((aligned(16))) unsigned char lds_raw[];
    LAS unsigned char* lds = (LAS unsigned char*)lds_raw;
    cg::grid_group grid = cg::this_grid();
    const int tid = threadIdx.x, lane = tid & 63, wave = __builtin_amdgcn_readfirstlane(tid >> 6), G = gridDim.x;
    const int gw = blockIdx.x * NWAVES + wave, NGW = G * NWAVES;
    volatile LAS unsigned* bst = (volatile LAS unsigned*)(lds + 131072 + 1024);
    if (tid == 0) { bst[0] = 0u; bst[1] = 0u; }
    __syncthreads();
    (void)xcd_barrier_post((unsigned*)(args.ws + WS_BAR), bst);
    grid.sync();
#define GSYNC() do { XcdBarrier b_; b_.bar = (unsigned*)(args.ws + WS_BAR); b_.x = xb_xcc_id(); b_.st = (volatile LAS unsigned*)(lds + 131072 + 1024); xcd_barrier(b_); } while (0)
#define OPQ(p) asm volatile("" : "+s"(p))
#define WSP(name) unsigned char* name = args.ws; OPQ(name)
    {   WSP(ws);
        p0_prologue(args, lds, tid, lane, wave, G);
#ifdef DIAG_FILL
        { v4u* z = (v4u*)(ws + WS_H); const size_t n16 = (WS_END - WS_H) / 16; const v4u zero = {0u, 0u, 0u, 0u};
          for (size_t i = (size_t)blockIdx.x * NTHR + tid; i < n16; i += (size_t)G * NTHR) z[i] = zero; }
#endif
        GSYNC();
        float* MOD = (float*)(ws + WS_MOD);
        ln_pass<0>(args.in[0], nullptr, (bf16*)(ws + WS_H), nullptr, nullptr, MOD + 1 * DM, MOD + 0 * DM, gw, NGW, lane);
        GSYNC();
        { const int l = 0; if (DBG_STAGE == 1) { dbg_dump(args.out, (const bf16*)(ws + WS_H), 1024, 1024, 0, tid, G); return; } } }
#pragma unroll 1
    for (int l = 0; l < DEPTH; ++l) {
#ifndef DBG_SKIP_ATT
#ifdef PROBE_DOUBLE_PAPB
#pragma unroll 1
        for (int rep = 0; rep < 2; ++rep) {
#endif
        {   WSP(ws); const unsigned char* wl = ws + WS_W + (size_t)l * LW;
            EpiQKP E{(bf16*)(ws + WS_R2), (bf16*)(ws + WS_PIN)}; run_gemm(lds, (const bf16*)(ws + WS_H), (const bf16*)(wl + OW_QK), T, NQKP, DM, 0, G, E); }
#pragma unroll 1
        for (int g = 0; g < 3; ++g) { WSP(ws); const unsigned char* wl = ws + WS_W + (size_t)l * LW;
            EpiVT E{(bf16*)(ws + WS_R3) + (size_t)g * 512 * T, 2 * g}; run_gemm(lds, (const bf16*)(wl + OW_V) + (size_t)g * 512 * DM, (const bf16*)(ws + WS_H), 512, T, DM, 2 * g, G, E); }
        DBG(2, dbg_dump(args.out, (const bf16*)(args.ws + WS_R2) + (size_t)T * 1024, 1024, 1024, 0, tid, G));
        DBG(3, dbg_dump(args.out, (const bf16*)(args.ws + WS_R3), 1024, 1024, 0, tid, G));
        GSYNC();
        {   WSP(ws); attn_phase(lds, (bf16*)(ws + WS_R2), (const bf16*)(ws + WS_R3), (float*)(ws + WS_LSE), G, tid, wave); }
        DBG(4, dbg_dump(args.out, (const bf16*)(args.ws + WS_R2) + (size_t)2 * T * 1024, 1024, 1024, 0, tid, G));
        GSYNC();
#ifdef PROBE_DOUBLE_PAPB
        }
#endif
        {   WSP(ws); combine_pool_phase((const bf16*)(ws + WS_R2), (const float*)(ws + WS_LSE), (const bf16*)(ws + WS_PIN), (bf16*)(ws + WS_R3), (bf16*)(ws + WS_R3 + 32 * MiB), gw, NGW, lane); }
        DBG(5, { dbg_dump(args.out, (const bf16*)(args.ws + WS_R3), 512, 512, 0, tid, G); dbg_dump(args.out, (const bf16*)(args.ws + WS_R3 + 32 * MiB), 512, 512, 512, tid, G); });
        GSYNC();
#endif
        {   WSP(ws); const unsigned char* wl = ws + WS_W + (size_t)l * LW;
            EpiSig E{(bf16*)(ws + WS_R2)}; run_gemm(lds, (const bf16*)(ws + WS_H), (const bf16*)(wl + OW_G), T, 2048, DM, 0, G, E); }
        DBG(11, dbg_dump(args.out, (const bf16*)(args.ws + WS_R2) + 1024, 2048, 1024, 0, tid, G));
        GSYNC();
        {   WSP(ws); const unsigned char* wl = ws + WS_W + (size_t)l * LW;
            EpiMerge<false> E{(const bf16*)(ws + WS_R2), (bf16*)(ws + WS_R2 + 128 * MiB), 0}; run_gemm(lds, (const bf16*)(ws + WS_R3), (const bf16*)(wl + OW_ATT), T, DM, 512, 0, G, E); }
        DBG(12, dbg_dump(args.out, (const bf16*)(args.ws + WS_R2 + 128 * MiB), 1024, 1024, 0, tid, G));
        GSYNC();
        {   WSP(ws); const unsigned char* wl = ws + WS_W + (size_t)l * LW;
            EpiMerge<true> E{(const bf16*)(ws + WS_R2), (bf16*)(ws + WS_R2 + 128 * MiB), 1024}; run_gemm(lds, (const bf16*)(ws + WS_R3 + 32 * MiB), (const bf16*)(wl + OW_PC), T, DM, 512, 0, G, E); }
        DBG(6, dbg_dump(args.out, (const bf16*)(args.ws + WS_R2 + 128 * MiB), 1024, 1024, 0, tid, G));
        GSYNC();
        {   WSP(ws); const unsigned char* wl = ws + WS_W + (size_t)l * LW; const float* modl = (const float*)(ws + WS_MOD) + (size_t)l * BATCH * NMOD;
            const float* xin = (l == 0) ? args.in[0] : args.out;
            EpiRes E{xin, args.out, modl + 2 * DM}; run_gemm(lds, (const bf16*)(ws + WS_R2 + 128 * MiB), (const bf16*)(wl + OW_O), T, DM, DM, 0, G, E); }
        DBG(7, (void)0);
        GSYNC();
        {   WSP(ws); const float* modl = (const float*)(ws + WS_MOD) + (size_t)l * BATCH * NMOD;
            ln_pass<1>(args.out, args.out, (bf16*)(ws + WS_H), args.in[10] + (size_t)l * DM, args.in[11] + (size_t)l * DM, modl + 4 * DM, modl + 3 * DM, gw, NGW, lane); }
        DBG(8, (void)0);
        GSYNC();
        {   WSP(ws); const unsigned char* wl = ws + WS_W + (size_t)l * LW;
            EpiSwiGLU E{(bf16*)(ws + WS_R2)}; run_gemm(lds, (const bf16*)(ws + WS_H), (const bf16*)(wl + OW_FI), T, 2 * DFF, DM, 0, G, E); }
        DBG(9, dbg_dump(args.out, (const bf16*)(args.ws + WS_R2), DFF, 1024, 0, tid, G));
        GSYNC();
        {   WSP(ws); const unsigned char* wl = ws + WS_W + (size_t)l * LW; const float* modl = (const float*)(ws + WS_MOD) + (size_t)l * BATCH * NMOD;
            EpiRes E{args.out, args.out, modl + 5 * DM}; run_gemm(lds, (const bf16*)(ws + WS_R2), (const bf16*)(wl + OW_FO), T, DM, DFF, 0, G, E); }
        DBG(10, (void)0);
        GSYNC();
        {   WSP(ws); const float* modl = (const float*)(ws + WS_MOD) + (size_t)l * BATCH * NMOD;
            if (l + 1 < DEPTH) ln_pass<1>(args.out, args.out, (bf16*)(ws + WS_H), args.in[14] + (size_t)l * DM, args.in[15] + (size_t)l * DM, modl + BATCH * NMOD + 1 * DM, modl + BATCH * NMOD + 0 * DM, gw, NGW, lane);
            else ln_pass<2>(args.out, args.out, nullptr, args.in[14] + (size_t)l * DM, args.in[15] + (size_t)l * DM, nullptr, nullptr, gw, NGW, lane); }
        if (l + 1 < DEPTH) GSYNC();
    }
}

extern "C" void kernel_launch(void* const* d_in, const int* in_sizes, int n_in, void* d_out, int out_size, void* d_ws, size_t ws_size, hipStream_t stream) {
    static int grid = 0;
    if (grid == 0) {
        if (n_in != 16 || out_size != T * DM || ws_size < WS_END) { fprintf(stderr, "kernel_launch: unexpected shapes (n_in %d, out %d, ws %zu < %zu)\n", n_in, out_size, ws_size, (size_t)WS_END); grid = -1; return; }
        int dev = 0, cus = 0, per_cu = 0;
        (void)hipGetDevice(&dev); (void)hipDeviceGetAttribute(&cus, hipDeviceAttributeMultiprocessorCount, dev);
        if (hipFuncSetAttribute((const void*)fwd_megakernel, hipFuncAttributeMaxDynamicSharedMemorySize, LDS_BYTES) != hipSuccess) { fprintf(stderr, "kernel_launch: hipFuncSetAttribute failed\n"); grid = -1; return; }
        if (hipOccupancyMaxActiveBlocksPerMultiprocessor(&per_cu, (const void*)fwd_megakernel, NTHR, LDS_BYTES) != hipSuccess || per_cu < 1) { fprintf(stderr, "kernel_launch: occupancy query says %d\n", per_cu); per_cu = 1; }
        (void)hipGetLastError();
        grid = cus * 1;
    }
    if (grid < 0) return;
    Args a{};
    for (int i = 0; i < 16; ++i) a.in[i] = (const float*)d_in[i];
    a.out = (float*)d_out; a.ws = (unsigned char*)d_ws;
    if (hipMemsetAsync((char*)d_ws + WS_BAR, 0, 16384, stream) != hipSuccess) { fprintf(stderr, "kernel_launch: hipMemsetAsync failed\n"); return; }
    void* kargs[] = {&a};
    hipError_t e = hipLaunchCooperativeKernel((const void*)fwd_megakernel, dim3(grid), dim3(NTHR), kargs, LDS_BYTES, stream);
    if (e != hipSuccess) fprintf(stderr, "kernel_launch: cooperative launch failed: %s (grid %d)\n", hipGetErrorString(e), grid);
}
```

```cpp
#define DBG_STAGE 0
#include <hip/hip_runtime.h>
#include <hip/hip_cooperative_groups.h>
#include <cstdio>
#include <cstdint>
namespace cg = cooperative_groups;

namespace pg8 {
#define PG8_LAS __attribute__((address_space(3)))
typedef unsigned short bf16_t;
typedef short bf16x8 __attribute__((ext_vector_type(8)));
typedef float f32x4 __attribute__((ext_vector_type(4)));
typedef unsigned u32x4 __attribute__((ext_vector_type(4)));
constexpr int BM = 256, BK = 64, HALF = 128, HTB = HALF * BK * 2  , STAGE_BYTES = 8 * HTB, NXCD = 8, WGM = 8;

__host__ __device__ __forceinline__ int lds_byte(int r, int c) { const int st = (r >> 4) * 2 + (c >> 5), rr = r & 15, cc = c & 31, ob = rr * 64 + cc * 2; return st * 1024 + (ob ^ (((ob >> 9) & 1) << 5)); }
__host__ __device__ __forceinline__ void stage_rc(int b, int& R, int& C) { const int st = b / 1024, sb = b % 1024, swz = sb ^ (((sb >> 9) & 1) << 5); R = (st >> 1) * 16 + swz / 64; C = (st & 1) * 32 + (swz % 64) / 2; }
__host__ __device__ __forceinline__ int perm32(int rho) { const int n = rho >> 4, i = rho & 15; return 8 * (i >> 2) + 4 * n + (i & 3); }

struct Unit { int pm, pn; };
struct Gemm { const bf16_t* A; const bf16_t* Bt; int M, N, K; int bshift; };

struct StaticOrder {
    int nM, nN, nwg, G, c;
    __host__ __device__ void init(int M, int N, int G_, int c_) { nM = M / BM; nN = N / BM; nwg = nM * nN; G = G_; c = c_; }
    __host__ __device__ bool next(int i, Unit& u) const {
        const long L = (long)i * G + c; if (L >= nwg) return false;
        int wgid = (int)L; { const int q = nwg / NXCD, r = nwg % NXCD, xcd = wgid % NXCD, off = wgid / NXCD; wgid = (xcd < r ? xcd * (q + 1) : r * (q + 1) + (xcd - r) * q) + off; }
        const int nig = WGM * nN, gid = wgid / nig, fm = gid * WGM, gsz = (nM - fm) < WGM ? (nM - fm) : WGM;
        u.pm = fm + ((wgid % nig) % gsz); u.pn = (wgid % nig) / gsz; return true;
    }
    __device__ __forceinline__ void a_ready(const Unit&) const {}
    __device__ __forceinline__ void done(const Unit&) const {}
};

__device__ __forceinline__ unsigned cvt_pk_bf16(float lo, float hi) { unsigned r; asm volatile("v_cvt_pk_bf16_f32 %0, %1, %2" : "=v"(r) : "v"(lo), "v"(hi)); return r; }
typedef float f32x2 __attribute__((ext_vector_type(2)));

template <class Epi, class Sched, bool ALIGN_EPI = false, bool SP2 = false>
__device__ __forceinline__ void gemm_phase(PG8_LAS unsigned char* lds, const Gemm g, const Sched& S, const Epi& E) {
    int tid_o = threadIdx.x; asm volatile("" : "+v"(tid_o));
    const int tid = tid_o, wid = __builtin_amdgcn_readfirstlane(tid >> 6), lane = tid & 63, wr = wid >> 2, wc = wid & 3, fr = lane & 15, fq = lane >> 4;
    const int K = g.K, nt = K / BK, bsh = g.bshift;
    unsigned voffA[2], voffB[2];
#pragma unroll
    for (int i = 0; i < 2; ++i) { int R, C; stage_rc(tid * 16 + i * 8192, R, C); int Rb = Epi::PERM ? ((R & ~31) + perm32(R & 31)) : R; if (bsh) { const int cnt = 256 >> bsh; Rb = ((Rb & (cnt - 1)) << bsh) + (Rb >> (8 - bsh)); }
        voffA[i] = (unsigned)(R * K + C) * 2u; voffB[i] = (unsigned)(Rb * K + C) * 2u; }
    const size_t kstep = (size_t)(BK * 2);
    const size_t hstep = (size_t)HALF * K * 2;
    const size_t hstepB = bsh ? ((size_t)(1 << (bsh - 1)) * K * 2) : hstep;
    const size_t tstep = 2 * hstep;
    const unsigned ldsw = (unsigned)wid * 1024u;
    const int aoff = lds_byte(wr * 64 + fr, fq * 8), boff = lds_byte(wc * 32 + fr, fq * 8);
#define PG8_SA(b, h) (((b) * 2 + (h)) * HTB)
#define PG8_SB(b, h) ((4 + (b) * 2 + (h)) * HTB)
#define PG8_STAGE(bufoff, gbase, voff) do { _Pragma("unroll") for (int _i = 0; _i < 2; ++_i) \
        __builtin_amdgcn_global_load_lds((const unsigned*)((const char*)(gbase) + (voff)[_i]), (PG8_LAS unsigned*)(lds + (bufoff) + ldsw + _i * 8192), 16, 0, 0); } while (0)
#define PG8_LDA(dst, b, h) do { _Pragma("unroll") for (int m = 0; m < 4; ++m) _Pragma("unroll") for (int k = 0; k < 2; ++k) dst[m][k] = *(const PG8_LAS bf16x8*)(lds + PG8_SA(b, h) + aoff + m * 2048 + k * 1024); } while (0)
#define PG8_LDB(dst, b, h) do { _Pragma("unroll") for (int n = 0; n < 2; ++n) _Pragma("unroll") for (int k = 0; k < 2; ++k) dst[n][k] = *(const PG8_LAS bf16x8*)(lds + PG8_SB(b, h) + boff + n * 2048 + k * 1024); } while (0)
#define PG8_MMA(ai, bj, At, Bt) do { __builtin_amdgcn_s_setprio(1); _Pragma("unroll") for (int m = 0; m < 4; ++m) _Pragma("unroll") for (int n = 0; n < 2; ++n) _Pragma("unroll") for (int k = 0; k < 2; ++k) \
        acc[ai][bj][m][n] = __builtin_amdgcn_mfma_f32_16x16x32_bf16(Bt[n][k], At[m][k], acc[ai][bj][m][n], 0, 0, 0); __builtin_amdgcn_s_setprio(0); } while (0)
#define PG8_WAIT_V(n) asm volatile("s_waitcnt vmcnt(" #n ")" ::: "memory")
#define PG8_WAIT_L(n) asm volatile("s_waitcnt lgkmcnt(" #n ")" ::: "memory")
#define PG8_BAR __builtin_amdgcn_s_barrier()
#define PG8_SCHED __builtin_amdgcn_sched_barrier(0)
    Unit cur, nxt; int ui = 0;
    if (!S.next(0, cur)) return;
    f32x4 acc[2][2][4][2];
#pragma unroll
    for (int a = 0; a < 2; ++a)
#pragma unroll
        for (int b = 0; b < 2; ++b)
#pragma unroll
            for (int m = 0; m < 4; ++m)
#pragma unroll
                for (int n = 0; n < 2; ++n) acc[a][b][m][n] = (f32x4){0.f, 0.f, 0.f, 0.f};
    bf16x8 At[4][2], B0[2][2], B1[2][2];
    const char* cA = (const char*)g.A + (size_t)cur.pm * tstep; const char* cB = (const char*)g.Bt + (size_t)cur.pn * tstep;
    S.a_ready(cur);
    if constexpr (SP2) {
        PG8_STAGE(PG8_SB(0, 0), cB, voffB); PG8_STAGE(PG8_SB(0, 1), cB + hstepB, voffB); PG8_STAGE(PG8_SA(0, 0), cA, voffA); PG8_STAGE(PG8_SA(0, 1), cA + hstep, voffA);
        if (wr == 1) PG8_BAR;
        PG8_WAIT_V(2); PG8_BAR;
        PG8_STAGE(PG8_SB(1, 0), cB + kstep, voffB); PG8_STAGE(PG8_SA(1, 0), cA + kstep, voffA); PG8_STAGE(PG8_SB(1, 1), cB + hstepB + kstep, voffB);
        PG8_WAIT_V(6); PG8_BAR;
    } else {
        PG8_STAGE(PG8_SB(0, 0), cB, voffB); PG8_STAGE(PG8_SA(0, 0), cA, voffA); PG8_STAGE(PG8_SB(0, 1), cB + hstepB, voffB); PG8_STAGE(PG8_SA(0, 1), cA + hstep, voffA);
        if (wr == 1) PG8_BAR;
        PG8_WAIT_V(4); PG8_BAR;
        PG8_STAGE(PG8_SB(1, 0), cB + kstep, voffB); PG8_STAGE(PG8_SA(1, 0), cA + kstep, voffA); PG8_STAGE(PG8_SB(1, 1), cB + hstepB + kstep, voffB);
        PG8_WAIT_V(6); PG8_BAR;
    }
    for (;;) {
        const bool has_next = S.next(ui + 1, nxt);
        const char* nA = has_next ? (const char*)g.A + (size_t)nxt.pm * tstep : cA; const char* nB = has_next ? (const char*)g.Bt + (size_t)nxt.pn * tstep : cB;
        for (int t = 0; t < nt; t += 2) {
            const bool last = (t == nt - 2);
            const char* a1 = cA + (size_t)(t + 1) * kstep;
            const char* a2 = last ? nA : cA + (size_t)(t + 2) * kstep; const char* b2 = last ? nB : cB + (size_t)(t + 2) * kstep;
            const char* a3 = a2 + kstep; const char* b3 = b2 + kstep;
            if (last && has_next) S.a_ready(nxt);
            if constexpr (SP2) {
            PG8_LDB(B0, 0, 0); PG8_LDB(B1, 0, 1); PG8_SCHED; PG8_LDA(At, 0, 0); PG8_STAGE(PG8_SA(1, 1), a1 + hstep, voffA);
            PG8_WAIT_V(8); PG8_WAIT_L(0); PG8_BAR; PG8_MMA(0, 0, At, B0); PG8_MMA(0, 1, At, B1); PG8_BAR; PG8_SCHED;
            PG8_LDA(At, 0, 1); PG8_STAGE(PG8_SB(0, 0), b2, voffB); PG8_STAGE(PG8_SB(0, 1), b2 + hstepB, voffB); PG8_STAGE(PG8_SA(0, 0), a2, voffA);
            PG8_WAIT_V(8); PG8_WAIT_L(0); PG8_BAR; PG8_MMA(1, 0, At, B0); PG8_MMA(1, 1, At, B1); PG8_BAR; PG8_SCHED;
            PG8_LDB(B0, 1, 0); PG8_LDB(B1, 1, 1); PG8_SCHED; PG8_LDA(At, 1, 0); PG8_STAGE(PG8_SA(0, 1), a2 + hstep, voffA);
            PG8_WAIT_V(8); PG8_WAIT_L(0); PG8_BAR; PG8_MMA(0, 0, At, B0); PG8_MMA(0, 1, At, B1); PG8_BAR; PG8_SCHED;
            PG8_LDA(At, 1, 1); PG8_STAGE(PG8_SB(1, 0), b3, voffB); PG8_STAGE(PG8_SB(1, 1), b3 + hstepB, voffB); PG8_STAGE(PG8_SA(1, 0), a3, voffA);
            PG8_WAIT_V(8); PG8_WAIT_L(0); PG8_BAR; PG8_MMA(1, 0, At, B0); PG8_MMA(1, 1, At, B1); PG8_BAR; PG8_SCHED;
            } else {
            PG8_LDB(B0, 0, 0); PG8_SCHED; PG8_LDA(At, 0, 0); PG8_STAGE(PG8_SA(1, 1), a1 + hstep, voffA);
            PG8_WAIT_L(8); PG8_BAR; PG8_WAIT_L(0); PG8_MMA(0, 0, At, B0); PG8_BAR; PG8_SCHED;
            PG8_LDB(B1, 0, 1); PG8_STAGE(PG8_SB(0, 0), b2, voffB);
            PG8_BAR; PG8_WAIT_L(0); PG8_MMA(0, 1, At, B1); PG8_BAR;
            PG8_LDA(At, 0, 1); PG8_STAGE(PG8_SA(0, 0), a2, voffA);
            PG8_BAR; PG8_WAIT_L(0); PG8_MMA(1, 0, At, B0); PG8_BAR; PG8_SCHED;
            PG8_STAGE(PG8_SB(0, 1), b2 + hstepB, voffB);
            PG8_WAIT_V(6); PG8_BAR; PG8_MMA(1, 1, At, B1); PG8_BAR;
            PG8_LDB(B0, 1, 0); PG8_SCHED; PG8_LDA(At, 1, 0); PG8_STAGE(PG8_SA(0, 1), a2 + hstep, voffA);
            PG8_WAIT_L(8); PG8_BAR; PG8_WAIT_L(0); PG8_MMA(0, 0, At, B0); PG8_BAR; PG8_SCHED;
            PG8_LDB(B1, 1, 1); PG8_STAGE(PG8_SB(1, 0), b3, voffB);
            PG8_BAR; PG8_WAIT_L(0); PG8_MMA(0, 1, At, B1); PG8_BAR;
            PG8_LDA(At, 1, 1); PG8_STAGE(PG8_SA(1, 0), a3, voffA);
            PG8_BAR; PG8_WAIT_L(0); PG8_MMA(1, 0, At, B0); PG8_BAR; PG8_SCHED;
            PG8_STAGE(PG8_SB(1, 1), b3 + hstepB, voffB);
            PG8_WAIT_V(6); PG8_BAR; PG8_MMA(1, 1, At, B1); PG8_BAR;
            }
        }
        if constexpr (ALIGN_EPI) { if (wr == 0) PG8_BAR; }
        if constexpr (!Epi::AFTER_DRAIN) { E(acc, cur, wr, wc, fr, fq); S.done(cur); }
        if (!has_next) break;
#pragma unroll
        for (int a = 0; a < 2; ++a)
#pragma unroll
            for (int b = 0; b < 2; ++b)
#pragma unroll
                for (int m = 0; m < 4; ++m)
#pragma unroll
                    for (int n = 0; n < 2; ++n) acc[a][b][m][n] = (f32x4){0.f, 0.f, 0.f, 0.f};
        cur = nxt; cA = nA; cB = nB; ++ui;
        if constexpr (ALIGN_EPI) { if (wr == 1) PG8_BAR; }
    }
    PG8_WAIT_V(0);
    if constexpr (!ALIGN_EPI) { if (wr == 0) PG8_BAR; }
    PG8_BAR;
    if constexpr (Epi::AFTER_DRAIN) { E.fused(acc, cur, wr, wc, fr, fq, lds, wid, lane); S.done(cur); }
#undef PG8_SA
#undef PG8_SB
#undef PG8_STAGE
#undef PG8_LDA
#undef PG8_LDB
#undef PG8_MMA
#undef PG8_WAIT_V
#undef PG8_WAIT_L
#undef PG8_BAR
#undef PG8_SCHED
}
}

constexpr int NWAVES = 8, NTHR = NWAVES * 64;
constexpr int BATCH = 4, SEQ = 8192, DM = 1024, DEPTH = 2, T = BATCH * SEQ;
constexpr int INW = 7168, DFF = 2816, NMOD = 6 * DM;
constexpr int NQKP = 3 * 1024 + 512;
constexpr float ALPHA = 1.41421356237309515f;
constexpr float LN_EPS = 1e-5f;
constexpr size_t MiB = 1u << 20;
constexpr size_t WS_MOD = 0;
constexpr size_t WS_BAR = 512 * 1024;
constexpr size_t WS_W = 1 * MiB;
constexpr size_t OW_QK = 0, OW_V = 7 * MiB, OW_G = 10 * MiB, OW_ATT = 14 * MiB, OW_PC = 15 * MiB, OW_O = 16 * MiB, OW_FI = 18 * MiB, OW_FO = 29 * MiB, LW = 34 * MiB + 512 * 1024;
constexpr size_t WS_H = WS_W + 2 * LW;
constexpr size_t WS_R2 = WS_H + 64 * MiB;
constexpr size_t WS_R3 = WS_R2 + 192 * MiB;
constexpr size_t WS_PIN = WS_R3 + 96 * MiB;
constexpr size_t WS_LSE = WS_PIN + 32 * MiB;
constexpr size_t WS_END = WS_LSE + 3 * MiB;
static_assert(WS_END <= 512 * MiB, "workspace map");
static_assert(OW_FO + (size_t)DM * DFF * 2 <= LW, "weight map");
constexpr int LDS_BYTES = 147456;

#define GAS __attribute__((address_space(1)))
#define LAS __attribute__((address_space(3)))
typedef unsigned short bf16;
typedef unsigned v4u __attribute__((ext_vector_type(4)));
typedef unsigned v2u __attribute__((ext_vector_type(2)));
typedef float f32x4 __attribute__((ext_vector_type(4)));
typedef float f32x16 __attribute__((ext_vector_type(16)));
typedef short bf16x8 __attribute__((ext_vector_type(8)));
typedef short s16x4 __attribute__((ext_vector_type(4)));
#define LDS_WAIT() asm volatile("s_waitcnt lgkmcnt(0)" ::: "memory")
__device__ __forceinline__ unsigned f2bf(float f) { unsigned u = __builtin_bit_cast(unsigned, f); return (u + 0x7fffu + ((u >> 16) & 1u)) >> 16; }
__device__ __forceinline__ unsigned pk2(float lo, float hi) { return f2bf(lo) | (f2bf(hi) << 16); }
__device__ __forceinline__ float bflo(unsigned w) { return __builtin_bit_cast(float, w << 16); }
__device__ __forceinline__ float bfhi(unsigned w) { return __builtin_bit_cast(float, w & 0xffff0000u); }
__device__ __forceinline__ float sigmoidf_(float x) { return __builtin_amdgcn_rcpf(1.0f + __expf(-x)); }
__device__ __forceinline__ float wave_sum(float v) {
#pragma unroll
    for (int o = 1; o < 64; o <<= 1) v += __shfl_xor(v, o);
    return v;
}
typedef __bf16 bf16x2_t __attribute__((ext_vector_type(2)));
typedef float f32x2_t __attribute__((ext_vector_type(2)));
__device__ __forceinline__ unsigned cvtpk(float lo, float hi) { f32x2_t v = {lo, hi}; bf16x2_t b = __builtin_convertvector(v, bf16x2_t); return __builtin_bit_cast(unsigned, b); }

typedef const f32x4 (&AccRef)[2][2][4][2];
#define CFENCE() asm volatile("" ::: "memory")

struct EpiQKP {
    static constexpr bool PERM = true, AFTER_DRAIN = false;
    bf16* QK; bf16* PIN;
    __device__ __forceinline__ void operator()(AccRef acc, const pg8::Unit& u, int wr, int wc, int fr, int fq) const {
        const int pn = u.pn; const bool isq = pn < 12;
        const int g = pn >> 2, sh = 2 * g, msk = (1 << sh) - 1, L = SEQ >> sh;
        bf16* base = isq ? QK + (size_t)g * T * 1024 + (pn & 3) * 256 : PIN + (pn - 12) * 256;
        const int pitch = isq ? 1024 : 512;
        const int col0 = wc * 32 + 8 * fq;
#pragma unroll
        for (int ai = 0; ai < 2; ++ai)
#pragma unroll
            for (int m = 0; m < 4; ++m) {
                const int r = u.pm * 256 + ai * 128 + wr * 64 + m * 16 + fr;
                unsigned prow = (unsigned)r;
                if (isq) { const int b = r >> 13, t = r & (SEQ - 1); prow = (unsigned)((b << 13) + (t & msk) * L + (t >> sh)); }
                const unsigned off = prow * (unsigned)pitch + (unsigned)col0;
#pragma unroll
                for (int bj = 0; bj < 2; ++bj) { const f32x4 v0 = acc[ai][bj][m][0], v1 = acc[ai][bj][m][1];
                    v4u w; w.x = cvtpk(v0[0], v0[1]); w.y = cvtpk(v0[2], v0[3]); w.z = cvtpk(v1[0], v1[1]); w.w = cvtpk(v1[2], v1[3]);
                    *(v4u*)(base + (off + bj * 128)) = w; }
                CFENCE(); }
    }
};
struct EpiVT {
    static constexpr bool PERM = true, AFTER_DRAIN = false;
    bf16* VTg; int sh;
    __device__ __forceinline__ void operator()(AccRef acc, const pg8::Unit& u, int wr, int wc, int fr, int fq) const {
        const int pn = u.pn, b = pn >> 5, tb = (pn & 31) * 256, L = SEQ >> sh, cntm = (256 >> sh) - 1;
#pragma unroll
        for (int ai = 0; ai < 2; ++ai)
#pragma unroll
            for (int m = 0; m < 4; ++m) {
                const int r = u.pm * 256 + ai * 128 + wr * 64 + m * 16 + fr;
                const unsigned roff = (unsigned)r * (unsigned)T + (unsigned)(b * SEQ + (tb >> sh));
#pragma unroll
                for (int bj = 0; bj < 2; ++bj) { const int s = bj * 128 + wc * 32 + 8 * fq, p = s >> (8 - sh), i = s & cntm;
                    const f32x4 v0 = acc[ai][bj][m][0], v1 = acc[ai][bj][m][1];
                    v4u w; w.x = cvtpk(v0[0], v0[1]); w.y = cvtpk(v0[2], v0[3]); w.z = cvtpk(v1[0], v1[1]); w.w = cvtpk(v1[2], v1[3]);
                    *(v4u*)(VTg + (roff + (unsigned)(p * L + i))) = w; }
                CFENCE(); }
    }
};
struct EpiSig {
    static constexpr bool PERM = true, AFTER_DRAIN = false;
    bf16* SG;
    __device__ __forceinline__ void operator()(AccRef acc, const pg8::Unit& u, int wr, int wc, int fr, int fq) const {
        const int col0 = u.pn * 256 + wc * 32 + 8 * fq;
#pragma unroll
        for (int ai = 0; ai < 2; ++ai)
#pragma unroll
            for (int m = 0; m < 4; ++m) {
                const int r = u.pm * 256 + ai * 128 + wr * 64 + m * 16 + fr;
                const unsigned off = (unsigned)r * 2048u + (unsigned)col0;
#pragma unroll
                for (int bj = 0; bj < 2; ++bj) { const f32x4 v0 = acc[ai][bj][m][0], v1 = acc[ai][bj][m][1];
                    v4u w; w.x = cvtpk(sigmoidf_(v0[0]), sigmoidf_(v0[1])); w.y = cvtpk(sigmoidf_(v0[2]), sigmoidf_(v0[3]));
                    w.z = cvtpk(sigmoidf_(v1[0]), sigmoidf_(v1[1])); w.w = cvtpk(sigmoidf_(v1[2]), sigmoidf_(v1[3]));
                    *(v4u*)(SG + (off + bj * 128)) = w; }
                CFENCE(); }
    }
};
template <bool ACCUM> struct EpiMerge {
    static constexpr bool PERM = true, AFTER_DRAIN = false;
    const bf16* SG; bf16* MG; int goff;
    __device__ __forceinline__ void operator()(AccRef acc, const pg8::Unit& u, int wr, int wc, int fr, int fq) const {
        const int col0 = u.pn * 256 + wc * 32 + 8 * fq;
#pragma unroll
        for (int ai = 0; ai < 2; ++ai)
#pragma unroll
            for (int m = 0; m < 4; ++m) {
                const int r = u.pm * 256 + ai * 128 + wr * 64 + m * 16 + fr;
                const unsigned so = (unsigned)r * 2048u + (unsigned)(goff + col0), mo = (unsigned)r * 1024u + (unsigned)col0;
#pragma unroll
                for (int bj = 0; bj < 2; ++bj) { const f32x4 v0 = acc[ai][bj][m][0], v1 = acc[ai][bj][m][1];
                    const v4u s = *(const v4u*)(SG + (so + bj * 128));
                    float o0 = bflo(s.x) * v0[0], o1 = bfhi(s.x) * v0[1], o2 = bflo(s.y) * v0[2], o3 = bfhi(s.y) * v0[3];
                    float o4 = bflo(s.z) * v1[0], o5 = bfhi(s.z) * v1[1], o6 = bflo(s.w) * v1[2], o7 = bfhi(s.w) * v1[3];
                    if (ACCUM) { const v4u q = *(const v4u*)(MG + (mo + bj * 128));
                        o0 += bflo(q.x); o1 += bfhi(q.x); o2 += bflo(q.y); o3 += bfhi(q.y); o4 += bflo(q.z); o5 += bfhi(q.z); o6 += bflo(q.w); o7 += bfhi(q.w); }
                    v4u w; w.x = cvtpk(o0, o1); w.y = cvtpk(o2, o3); w.z = cvtpk(o4, o5); w.w = cvtpk(o6, o7);
                    *(v4u*)(MG + (mo + bj * 128)) = w; }
                CFENCE(); }
    }
};
struct EpiRes {
    static constexpr bool PERM = false, AFTER_DRAIN = false;
    const float* xin; float* XB; const float* gate;
    __device__ __forceinline__ void operator()(AccRef acc, const pg8::Unit& u, int wr, int wc, int fr, int fq) const {
        const int col0 = u.pn * 256 + wc * 32 + 4 * fq; const int b = u.pm >> 5;
        f32x4 gv[2][2];
#pragma unroll
        for (int bj = 0; bj < 2; ++bj)
#pragma unroll
            for (int n = 0; n < 2; ++n) gv[bj][n] = *(const f32x4*)(gate + (unsigned)(b * NMOD + col0 + bj * 128 + n * 16)) + 1.0f;
#pragma unroll
        for (int ai = 0; ai < 2; ++ai)
#pragma unroll
            for (int m = 0; m < 4; ++m) {
                const int r = u.pm * 256 + ai * 128 + wr * 64 + m * 16 + fr; const unsigned off = (unsigned)r * (unsigned)DM + (unsigned)col0;
#pragma unroll
                for (int bj = 0; bj < 2; ++bj)
#pragma unroll
                    for (int n = 0; n < 2; ++n) { const f32x4 xv = *(const f32x4*)(xin + off + bj * 128 + n * 16);
                        *(f32x4*)(XB + off + bj * 128 + n * 16) = xv * ALPHA + gv[bj][n] * acc[ai][bj][m][n]; }
                CFENCE(); }
    }
};
struct EpiSwiGLU {
    static constexpr bool PERM = true, AFTER_DRAIN = false;
    bf16* HID;
    __device__ __forceinline__ void operator()(AccRef acc, const pg8::Unit& u, int wr, int wc, int fr, int fq) const {
        const int col0 = u.pn * 128 + wc * 32 + 8 * fq;
#pragma unroll
        for (int ai = 0; ai < 2; ++ai)
#pragma unroll
            for (int m = 0; m < 4; ++m) {
                const int r = u.pm * 256 + ai * 128 + wr * 64 + m * 16 + fr;
                float o[8];
#pragma unroll
                for (int n = 0; n < 2; ++n)
#pragma unroll
                    for (int e = 0; e < 4; ++e) { const float a = acc[ai][0][m][n][e], bb = acc[ai][1][m][n][e]; o[4 * n + e] = a * sigmoidf_(a) * bb; }
                v4u w; w.x = cvtpk(o[0], o[1]); w.y = cvtpk(o[2], o[3]); w.z = cvtpk(o[4], o[5]); w.w = cvtpk(o[6], o[7]);
                *(v4u*)(HID + ((unsigned)r * (unsigned)DFF + (unsigned)col0)) = w; CFENCE(); }
    }
};

template <int MAP> __device__ __forceinline__ int srccol(int n) {
    if (MAP == 1) { return n < 3072 ? (n >> 10) * 1536 + (n & 1023) : 4608 + (n - 3072); }
    if (MAP == 2) { return (n >> 9) * 1536 + 1024 + (n & 511); }
    if (MAP == 3) { return 5120 + n; }
    if (MAP == 4) { return ((n >> 7) & 1) * DFF + (n >> 8) * 128 + (n & 127); }
    return n;
}
template <int MAP> __device__ __forceinline__ void transpose_mat(const float* W, int K, int Nsrc, bf16* WT, int Ndst, LAS float* scr, int gw, int NGW, int lane) {
    const int nblk = Ndst / 32, nitems = (K / 64) * nblk;
    for (int item = gw; item < nitems; item += NGW) {
        const int kb = item / nblk, nb = item % nblk, k0 = 64 * kb, n0 = 32 * nb, s0 = srccol<MAP>(n0);
#pragma unroll 8
        for (int i = 0; i < 32; ++i) { const int kk = 2 * i + (lane >> 5); scr[kk * 33 + (lane & 31)] = W[(size_t)(k0 + kk) * Nsrc + s0 + (lane & 31)]; }
        LDS_WAIT(); asm volatile("" ::: "memory");
        const int c = lane & 7;
#pragma unroll
        for (int j = 0; j < 4; ++j) { const int n = (lane >> 3) + 8 * j; const LAS float* s = scr + (8 * c) * 33 + n;
            v4u o; o.x = pk2(s[0 * 33], s[1 * 33]); o.y = pk2(s[2 * 33], s[3 * 33]); o.z = pk2(s[4 * 33], s[5 * 33]); o.w = pk2(s[6 * 33], s[7 * 33]);
            *(v4u*)(WT + (size_t)(n0 + n) * K + k0 + 8 * c) = o; }
        LDS_WAIT(); asm volatile("" ::: "memory");
    }
}
struct Args { const float* in[16]; float* out; unsigned char* ws; };

__device__ __forceinline__ void p0_prologue(const Args& A, LAS unsigned char* lds, int tid, int lane, int wave, int G) {
    LAS float* scr = (LAS float*)(lds + wave * 16384);
    const int gw = blockIdx.x * NWAVES + wave, NGW = G * NWAVES;
    for (int l = 0; l < DEPTH; ++l) {
        unsigned char* wl = A.ws + WS_W + (size_t)l * LW;
        const float* w_in = A.in[4] + (size_t)l * DM * INW;
        transpose_mat<1>(w_in, DM, INW, (bf16*)(wl + OW_QK), NQKP, scr, gw, NGW, lane);
        transpose_mat<2>(w_in, DM, INW, (bf16*)(wl + OW_V), 1536, scr, gw, NGW, lane);
        transpose_mat<3>(w_in, DM, INW, (bf16*)(wl + OW_G), 2048, scr, gw, NGW, lane);
        transpose_mat<0>(A.in[7] + (size_t)l * 512 * DM, 512, DM, (bf16*)(wl + OW_ATT), DM, scr, gw, NGW, lane);
        transpose_mat<0>(A.in[9] + (size_t)l * DM * DM, DM, DM, (bf16*)(wl + OW_O), DM, scr, gw, NGW, lane);
        transpose_mat<4>(A.in[12] + (size_t)l * DM * 2 * DFF, DM, 2 * DFF, (bf16*)(wl + OW_FI), 2 * DFF, scr, gw, NGW, lane);
        transpose_mat<0>(A.in[13] + (size_t)l * DFF * DM, DFF, DM, (bf16*)(wl + OW_FO), DM, scr, gw, NGW, lane);
        const float* mix = A.in[5] + (size_t)l * 4 * 128 * 128; const float* psc = A.in[6] + (size_t)l * 512; const float* wpo = A.in[8] + (size_t)l * 512 * DM;
        bf16* wpc = (bf16*)(wl + OW_PC);
        for (int o = (blockIdx.x * NTHR + tid); o < 128 * DM; o += G * NTHR) {
            const int n = o & 1023, k4 = (o >> 10) * 4, gg = k4 >> 7; float a0 = 0.f, a1 = 0.f, a2 = 0.f, a3 = 0.f;
            const float* mr = mix + (size_t)gg * 128 * 128 + (size_t)(k4 & 127) * 128;
            for (int j = 0; j < 128; ++j) { const float wv = psc[gg * 128 + j] * wpo[(size_t)(gg * 128 + j) * DM + n];
                a0 += mr[j] * wv; a1 += mr[128 + j] * wv; a2 += mr[256 + j] * wv; a3 += mr[384 + j] * wv; }
            v2u w; w.x = pk2(a0, a1); w.y = pk2(a2, a3); *(v2u*)(wpc + (size_t)n * 512 + k4) = w;
        }
    }
    __syncthreads();
    {
        LAS float* red = (LAS float*)lds;
        const float* c = A.in[1]; float* MOD = (float*)(A.ws + WS_MOD);
        const int ks = tid >> 6, col = tid & 63;
        for (int item = blockIdx.x; item < DEPTH * NMOD / 64; item += G) {
            const int l = item / (NMOD / 64), n = (item % (NMOD / 64)) * 64 + col;
            const float* w = A.in[2] + (size_t)l * DM * NMOD + n;
            float a0 = 0.f, a1 = 0.f, a2 = 0.f, a3 = 0.f;
            for (int k = ks * 128; k < ks * 128 + 128; ++k) { const float wv = w[(size_t)k * NMOD];
                const float c0 = c[k], c1 = c[DM + k], c2 = c[2 * DM + k], c3 = c[3 * DM + k];
                a0 += c0 * sigmoidf_(c0) * wv; a1 += c1 * sigmoidf_(c1) * wv; a2 += c2 * sigmoidf_(c2) * wv; a3 += c3 * sigmoidf_(c3) * wv; }
            red[(ks * 4 + 0) * 64 + col] = a0; red[(ks * 4 + 1) * 64 + col] = a1; red[(ks * 4 + 2) * 64 + col] = a2; red[(ks * 4 + 3) * 64 + col] = a3;
            __syncthreads();
            if (tid < 256) { const int b = tid >> 6; float s = 0.f;
#pragma unroll
                for (int q = 0; q < 8; ++q) s += red[(q * 4 + b) * 64 + col];
                MOD[((size_t)l * BATCH + b) * NMOD + n] = s + A.in[3][(size_t)l * NMOD + n]; }
            __syncthreads();
        }
    }
}

template <int MODE> __device__ __forceinline__ void ln_pass(const float* in, float* out, bf16* H, const float* lg, const float* lb, const float* sc, const float* sh, int gw, int NGW, int lane_) {
    int lane = lane_; asm volatile("" : "+v"(lane));
    for (int row0 = gw; row0 < T; row0 += 2 * NGW) {
        f32x4 v[2][4]; float mean[2], rstd[2]; bool ok[2];
#pragma unroll
        for (int q = 0; q < 2; ++q) { const int row = row0 + q * NGW; ok[q] = row < T; const f32x4* xr = (const f32x4*)(in + (size_t)(ok[q] ? row : row0) * DM) + lane;
#pragma unroll
            for (int j = 0; j < 4; ++j) v[q][j] = xr[64 * j]; }
#pragma unroll
        for (int q = 0; q < 2; ++q) { float s = 0.f;
#pragma unroll
            for (int j = 0; j < 4; ++j) s += (v[q][j].x + v[q][j].y) + (v[q][j].z + v[q][j].w);
            mean[q] = wave_sum(s) * (1.f / DM); float s2 = 0.f;
#pragma unroll
            for (int j = 0; j < 4; ++j) { v[q][j] = v[q][j] - mean[q]; s2 += (v[q][j].x * v[q][j].x + v[q][j].y * v[q][j].y) + (v[q][j].z * v[q][j].z + v[q][j].w * v[q][j].w); }
            rstd[q] = 1.f / sqrtf(wave_sum(s2) * (1.f / DM) + LN_EPS); }
        if (MODE != 0) {
#pragma unroll
            for (int q = 0; q < 2; ++q) { const int row = row0 + q * NGW; if (!ok[q]) continue;
                f32x4* orow = (f32x4*)(out + (size_t)row * DM) + lane; float s = 0.f;
#pragma unroll
                for (int j = 0; j < 4; ++j) { const f32x4 gg = ((const f32x4*)lg)[lane + 64 * j], bb = ((const f32x4*)lb)[lane + 64 * j];
                    v[q][j] = v[q][j] * rstd[q] * gg + bb; orow[64 * j] = v[q][j]; s += (v[q][j].x + v[q][j].y) + (v[q][j].z + v[q][j].w); }
                if (MODE == 2) continue;
                mean[q] = wave_sum(s) * (1.f / DM); float s2 = 0.f;
#pragma unroll
                for (int j = 0; j < 4; ++j) { v[q][j] = v[q][j] - mean[q]; s2 += (v[q][j].x * v[q][j].x + v[q][j].y * v[q][j].y) + (v[q][j].z * v[q][j].z + v[q][j].w * v[q][j].w); }
                rstd[q] = 1.f / sqrtf(wave_sum(s2) * (1.f / DM) + LN_EPS); }
            if (MODE == 2) continue;
        }
#pragma unroll
        for (int q = 0; q < 2; ++q) { const int row = row0 + q * NGW; if (!ok[q]) continue; const int b = row >> 13;
            v2u* hrow = (v2u*)(H + (size_t)row * DM) + lane;
#pragma unroll
            for (int j = 0; j < 4; ++j) { const f32x4 a = ((const f32x4*)(sc + (size_t)b * NMOD))[lane + 64 * j] + 1.0f, d = ((const f32x4*)(sh + (size_t)b * NMOD))[lane + 64 * j];
                const f32x4 h = v[q][j] * rstd[q] * a + d; v2u w; w.x = pk2(h.x, h.y); w.y = pk2(h.z, h.w); hrow[64 * j] = w; } }
    }
}

#define MFMA32(a, b, c) __builtin_amdgcn_mfma_f32_32x32x16_bf16((a), (b), (c), 0, 0, 0)
constexpr int KPITCH = 144, VPITCH = 776, ATT_VOFF = 384 * KPITCH;
struct AttnUnitId { int g, b, h, p, qblk; };
__device__ __forceinline__ AttnUnitId attn_decode(int u) {
    AttnUnitId r; const int pq = u & 31; r.h = (u >> 5) & 7; r.b = (u >> 8) & 3; r.g = u >> 10; const int L256 = (SEQ >> (2 * r.g)) >> 8; r.p = pq / L256; r.qblk = pq % L256; return r;
}
__device__ __forceinline__ void attn_stage_load(v4u (&kreg)[6], v4u (&vreg)[6], const bf16* QK, const bf16* VT, const AttnUnitId& id, int tid) {
    const int sh = 2 * id.g, L = SEQ >> sh, klo = id.qblk * 256 - 64;
    const bf16* QKg = QK + (size_t)id.g * T * 1024; const bf16* VTg = VT + (size_t)id.g * 512 * T;
    const unsigned rowbase = (unsigned)(id.b * SEQ + id.p * L);
#pragma unroll
    for (int i = 0; i < 6; ++i) { const int c = tid + 512 * i, row = c >> 3, piece = c & 7, key = klo + row;
        kreg[i] = (v4u){0u, 0u, 0u, 0u};
        if (key >= 0 && key < L) kreg[i] = *(const v4u*)(QKg + ((rowbase + (unsigned)key) * 1024u + (unsigned)(512 + id.h * 64 + piece * 8))); }
#pragma unroll
    for (int i = 0; i < 6; ++i) { const int c = tid + 512 * i, d = c / 48, piece = c - d * 48, key = klo + piece * 8;
        vreg[i] = (v4u){0u, 0u, 0u, 0u};
        if (key >= 0 && key < L) vreg[i] = *(const v4u*)(VTg + ((unsigned)(id.h * 64 + d) * (unsigned)T + rowbase + (unsigned)key)); }
}
__device__ __forceinline__ void attn_stage_write(LAS unsigned char* lds, const v4u (&kreg)[6], const v4u (&vreg)[6], int tid) {
#pragma unroll
    for (int i = 0; i < 6; ++i) { const int c = tid + 512 * i, row = c >> 3, piece = c & 7; *(LAS v4u*)(lds + row * KPITCH + piece * 16) = kreg[i]; }
#pragma unroll
    for (int i = 0; i < 6; ++i) { const int c = tid + 512 * i, d = c / 48, piece = c - d * 48; LAS v2u* dst = (LAS v2u*)(lds + ATT_VOFF + d * VPITCH + piece * 16);
        dst[0] = (v2u){vreg[i].x, vreg[i].y}; dst[1] = (v2u){vreg[i].z, vreg[i].w}; }
}
__device__ __forceinline__ void attn_compute(LAS unsigned char* lds, bf16* QK, float* LSE, const AttnUnitId& id, int lane, int wave) {
    const int sh = 2 * id.g, L = SEQ >> sh, a = lane & 31, hi = lane >> 5, q0 = id.qblk * 256 + 32 * wave, h = id.h;
    bf16* QKg = QK + (size_t)id.g * T * 1024; float* LSEg = LSE + (size_t)id.g * T * 8;
    const float sr = exp2f(-8.0f * (float)(id.g * 8 + h + 1) / 24.0f) * (float)(1 << sh);
    const unsigned rowbase = (unsigned)(id.b * SEQ + id.p * L);
    const unsigned qoff = (rowbase + (unsigned)(q0 + a)) * 1024u + (unsigned)(h * 64);
    bf16x8 qf[4];
#pragma unroll
    for (int s = 0; s < 4; ++s) qf[s] = *(const bf16x8*)(QKg + (qoff + (unsigned)(16 * s + 8 * hi)));
    const float xf = (float)(4 * hi - a);
    f32x16 st[5];
    float mx = -1e30f;
    const LAS unsigned char* kl = lds + (32 * wave + a) * KPITCH + 16 * hi;
#pragma unroll
    for (int j = 0; j < 5; ++j) {
        const int kt0 = q0 - 64 + 32 * j; const bool inr = (kt0 >= 0) && (kt0 < L);
        f32x16 acc;
#pragma unroll
        for (int e = 0; e < 16; ++e) acc[e] = 0.f;
        if (inr) {
            bf16x8 kf[4];
#pragma unroll
            for (int s = 0; s < 4; ++s) kf[s] = *(const LAS bf16x8*)(kl + 32 * j * KPITCH + 32 * s);
#pragma unroll
            for (int s = 0; s < 4; ++s) acc = MFMA32(kf[s], qf[s], acc);
        }
#pragma unroll
        for (int e = 0; e < 16; ++e) {
            const float t = xf + (float)(32 * j - 64 + (e & 3) + 8 * (e >> 2));
            float v = fmaf(acc[e], 0.125f, -sr * fabsf(t));
            if (j == 0) v += fminf(t + 64.0f, 0.f) * 1e30f;
            if (j == 4) v += fminf(64.0f - t, 0.f) * 1e30f;
            if (!inr) v = -1e30f;
            acc[e] = v; mx = fmaxf(mx, v);
        }
        st[j] = acc;
    }
    mx = fmaxf(mx, __shfl_xor(mx, 32));
    float lsum = 0.f; const float mxl = mx * 1.44269504089f;
#pragma unroll
    for (int j = 0; j < 5; ++j)
#pragma unroll
        for (int e = 0; e < 16; ++e) { const float pv = __builtin_amdgcn_exp2f(fmaf(st[j][e], 1.44269504089f, -mxl)); st[j][e] = pv; lsum += pv; }
    lsum += __shfl_xor(lsum, 32);
    f32x16 o0, o1;
#pragma unroll
    for (int e = 0; e < 16; ++e) { o0[e] = 0.f; o1[e] = 0.f; }
    const LAS unsigned char* vl = lds + ATT_VOFF + a * VPITCH + (32 * wave + 4 * hi) * 2;
#pragma unroll
    for (int j = 0; j < 5; ++j) {
        const int kt0 = q0 - 64 + 32 * j; const bool inr = (kt0 >= 0) && (kt0 < L);
        if (inr) {
#pragma unroll
            for (int s2 = 0; s2 < 2; ++s2) {
                v4u pw; pw.x = cvtpk(st[j][8 * s2 + 0], st[j][8 * s2 + 1]); pw.y = cvtpk(st[j][8 * s2 + 2], st[j][8 * s2 + 3]);
                pw.z = cvtpk(st[j][8 * s2 + 4], st[j][8 * s2 + 5]); pw.w = cvtpk(st[j][8 * s2 + 6], st[j][8 * s2 + 7]);
                const bf16x8 pf = __builtin_bit_cast(bf16x8, pw);
                const LAS unsigned char* vp = vl + (32 * j + 16 * s2) * 2;
                v4u va, vb;
                { const v2u x0 = *(const LAS v2u*)(vp), x1 = *(const LAS v2u*)(vp + 16); va.x = x0.x; va.y = x0.y; va.z = x1.x; va.w = x1.y; }
                { const v2u x0 = *(const LAS v2u*)(vp + 32 * VPITCH), x1 = *(const LAS v2u*)(vp + 32 * VPITCH + 16); vb.x = x0.x; vb.y = x0.y; vb.z = x1.x; vb.w = x1.y; }
                o0 = MFMA32(__builtin_bit_cast(bf16x8, va), pf, o0);
                o1 = MFMA32(__builtin_bit_cast(bf16x8, vb), pf, o1);
            }
        }
    }
    const float inv = 1.0f / lsum;
#pragma unroll
    for (int gq = 0; gq < 4; ++gq) {
        v2u w0, w1;
        w0.x = cvtpk(o0[4 * gq] * inv, o0[4 * gq + 1] * inv); w0.y = cvtpk(o0[4 * gq + 2] * inv, o0[4 * gq + 3] * inv);
        w1.x = cvtpk(o1[4 * gq] * inv, o1[4 * gq + 1] * inv); w1.y = cvtpk(o1[4 * gq + 2] * inv, o1[4 * gq + 3] * inv);
        *(v2u*)(QKg + (qoff + (unsigned)(8 * gq + 4 * hi))) = w0; *(v2u*)(QKg + (qoff + (unsigned)(32 + 8 * gq + 4 * hi))) = w1;
    }
    if (hi == 0) LSEg[((unsigned)(id.b * SEQ + id.p) + ((unsigned)(q0 + a) << sh)) * 8u + (unsigned)h] = mx + __logf(lsum);
}
__device__ __forceinline__ void attn_phase(LAS unsigned char* lds, bf16* QK, const bf16* VT, float* LSE, int G, int tid_, int wave) {
    constexpr int NU = 3 * BATCH * 8 * 32;
    int tid = tid_; asm volatile("" : "+v"(tid));
    v4u kreg[6], vreg[6];
    int u = blockIdx.x;
    if (u < NU) attn_stage_load(kreg, vreg, QK, VT, attn_decode(u), tid);
    for (; u < NU; u += G) {
        attn_stage_write(lds, kreg, vreg, tid);
        __syncthreads();
        if (u + G < NU) attn_stage_load(kreg, vreg, QK, VT, attn_decode(u + G), tid);
        { int t2 = tid; asm volatile("" : "+v"(t2)); attn_compute(lds, QK, LSE, attn_decode(u), t2 & 63, wave); }
        __syncthreads();
    }
}

__device__ __forceinline__ void combine_pool_phase(const bf16* QK, const float* LSE, const bf16* PIN, bf16* ATT, bf16* POOLED, int gw, int NGW, int lane_) {
    int lane = lane_; asm volatile("" : "+v"(lane));
    const int per = (T + NGW - 1) / NGW;
    for (int tok = gw * per; tok < T && tok < (gw + 1) * per; ++tok) {
        const int b = tok >> 13, t = tok & (SEQ - 1);
        {
            const int hh = lane >> 3, d0 = (lane & 7) * 8;
            const float l0 = LSE[((size_t)0 * T + tok) * 8 + hh], l1 = LSE[((size_t)1 * T + tok) * 8 + hh], l2 = LSE[((size_t)2 * T + tok) * 8 + hh];
            const float m = fmaxf(l0, fmaxf(l1, l2)); float w0 = __expf(l0 - m), w1 = __expf(l1 - m), w2 = __expf(l2 - m);
            const float inv = 1.0f / (w0 + w1 + w2); w0 *= inv; w1 *= inv; w2 *= inv;
            const size_t r0 = (size_t)tok, r1 = ((size_t)b << 13) + (size_t)(t & 3) * (SEQ / 4) + (t >> 2), r2 = ((size_t)b << 13) + (size_t)(t & 15) * (SEQ / 16) + (t >> 4);
            const v4u a0 = *(const v4u*)(QK + r0 * 1024 + hh * 64 + d0), a1 = *(const v4u*)(QK + ((size_t)T + r1) * 1024 + hh * 64 + d0), a2 = *(const v4u*)(QK + ((size_t)2 * T + r2) * 1024 + hh * 64 + d0);
            v4u w;
            w.x = pk2(w0 * bflo(a0.x) + w1 * bflo(a1.x) + w2 * bflo(a2.x), w0 * bfhi(a0.x) + w1 * bfhi(a1.x) + w2 * bfhi(a2.x));
            w.y = pk2(w0 * bflo(a0.y) + w1 * bflo(a1.y) + w2 * bflo(a2.y), w0 * bfhi(a0.y) + w1 * bfhi(a1.y) + w2 * bfhi(a2.y));
            w.z = pk2(w0 * bflo(a0.z) + w1 * bflo(a1.z) + w2 * bflo(a2.z), w0 * bfhi(a0.z) + w1 * bfhi(a1.z) + w2 * bfhi(a2.z));
            w.w = pk2(w0 * bflo(a0.w) + w1 * bflo(a1.w) + w2 * bflo(a2.w), w0 * bfhi(a0.w) + w1 * bfhi(a1.w) + w2 * bfhi(a2.w));
            *(v4u*)(ATT + (size_t)tok * 512 + hh * 64 + d0) = w;
        }
        {
            const int half = 1 << (lane >> 4), lo = (t - half) < 0 ? 0 : (t - half), hi = (t + half) > SEQ ? SEQ : (t + half);
            const bf16* base = PIN + ((size_t)b << 13) * 512 + lane * 8;
            float s[8];
#pragma unroll
            for (int e = 0; e < 8; ++e) s[e] = 0.f;
            for (int tt = lo; tt < hi; ++tt) { const v4u x = *(const v4u*)(base + (size_t)tt * 512);
                s[0] += bflo(x.x); s[1] += bfhi(x.x); s[2] += bflo(x.y); s[3] += bfhi(x.y); s[4] += bflo(x.z); s[5] += bfhi(x.z); s[6] += bflo(x.w); s[7] += bfhi(x.w); }
            const float rc = 1.0f / (float)(hi - lo); const v4u x = *(const v4u*)(base + (size_t)t * 512);
            v4u w; w.x = pk2(s[0] * rc - bflo(x.x), s[1] * rc - bfhi(x.x)); w.y = pk2(s[2] * rc - bflo(x.y), s[3] * rc - bfhi(x.y));
            w.z = pk2(s[4] * rc - bflo(x.z), s[5] * rc - bfhi(x.z)); w.w = pk2(s[6] * rc - bflo(x.w), s[7] * rc - bfhi(x.w));
            *(v4u*)(POOLED + (size_t)tok * 512 + lane * 8) = w;
        }
    }
}

#define XB_TMO      128
#define XB_XCNT(j)  (256  + 64 * (j))
#define XB_XSUB(j)  (1280 + 64 * (j))
#define XB_XGEN(j)  (2304 + 64 * (j))
#define XB_TOP      3328
#define XB_TOPGEN   3392
#define XCD_BAR_WORDS 3456
#define XB_SPIN_CAP (1u << 18)

__device__ __forceinline__ unsigned xb_ld(unsigned* p)              { return __hip_atomic_load(p, __ATOMIC_RELAXED, __HIP_MEMORY_SCOPE_AGENT); }
__device__ __forceinline__ unsigned xb_add(unsigned* p, unsigned v) { return __hip_atomic_fetch_add(p, v, __ATOMIC_RELAXED, __HIP_MEMORY_SCOPE_AGENT); }
__device__ __forceinline__ unsigned xb_xcc_id() { return (unsigned)__builtin_amdgcn_s_getreg((3 << 11) | 20) & 0xFu; }
#define XB_SPIN(cond, bar) do { unsigned _sp = 0; while (cond) { __builtin_amdgcn_s_sleep(1); \
    if ((++_sp & 255u) == 0u) { if (xb_ld(&(bar)[XB_TMO])) break; if (_sp > XB_SPIN_CAP) { atomicAdd(&(bar)[XB_TMO], 1u); break; } } } } while (0)

struct XcdBarrier {
    unsigned* bar; unsigned x;
    volatile LAS unsigned* st;
};

__device__ __forceinline__ XcdBarrier xcd_barrier_post(unsigned* bar, volatile LAS unsigned* st) {
    XcdBarrier b; b.bar = bar; b.x = xb_xcc_id(); b.st = st;
    if (threadIdx.x == 0) (void)xb_add(&bar[XB_XCNT(b.x)], 1u);
    return b;
}
__device__ __forceinline__ void xcd_barrier_complete(unsigned* bar, unsigned x, unsigned& nloc, unsigned& nx) {
    const unsigned G = gridDim.x * gridDim.y * gridDim.z;
    unsigned sum, cnt, mine, sp = 0u;
    for (;;) {
        sum = 0u; cnt = 0u; mine = 0u;
#pragma unroll
        for (unsigned j = 0; j < 16; ++j) { const unsigned c = xb_ld(&bar[XB_XCNT(j)]); sum += c; cnt += (c > 0u) ? 1u : 0u; mine = (j == x) ? c : mine; }
        if (sum == G) break;
        __builtin_amdgcn_s_sleep(1);
        if ((++sp & 255u) == 0u) { if (xb_ld(&bar[XB_TMO])) break; if (sp > XB_SPIN_CAP) { atomicAdd(&bar[XB_TMO], 1u); break; } }
    }
    nloc = mine > 0u ? mine : 1u; nx = cnt > 0u ? cnt : 1u;
}

__device__ __forceinline__ void xcd_barrier(const XcdBarrier& b) {
    asm volatile("s_waitcnt vmcnt(0)" ::: "memory");
    __syncthreads();
    if (threadIdx.x == 0) {
        unsigned* bar = b.bar;
        __builtin_amdgcn_s_waitcnt(0);
        unsigned nloc = b.st[0], nx = b.st[1];
        if (nloc == 0u) { xcd_barrier_complete(bar, b.x, nloc, nx); b.st[0] = nloc; b.st[1] = nx; }
        const unsigned old = xb_add(&bar[XB_XSUB(b.x)], 1u);
        const unsigned gen = old / nloc;
        if (old + 1u == (gen + 1u) * nloc) {
            __builtin_amdgcn_fence(__ATOMIC_RELEASE, "agent");
            asm volatile("s_waitcnt vmcnt(0)" ::: "memory");
            const unsigned og = xb_add(&bar[XB_TOP], 1u);
            const unsigned tg = og / nx;
            if (og + 1u == (tg + 1u) * nx) xb_add(&bar[XB_TOPGEN], 1u);
            else XB_SPIN(xb_ld(&bar[XB_TOPGEN]) == tg, bar);
            __builtin_amdgcn_fence(__ATOMIC_ACQUIRE, "agent");
            xb_add(&bar[XB_XGEN(b.x)], 1u);
            asm volatile("s_waitcnt vmcnt(0)" ::: "memory");
        } else {
            XB_SPIN(xb_ld(&bar[XB_XGEN(b.x)]) == gen, bar);
            __builtin_amdgcn_fence(__ATOMIC_ACQUIRE, "agent");
            asm volatile("s_waitcnt vmcnt(0)" ::: "memory");
        }
    }
    __syncthreads();
}

#ifndef DBG_STAGE
#define DBG_STAGE 0
#endif
__device__ __forceinline__ void dbg_dump(float* out, const bf16* src, int pitch, int ncols, int coloff, int tid, int G) {
    const size_t n = (size_t)T * ncols;
    for (size_t i = (size_t)blockIdx.x * NTHR + tid; i < n; i += (size_t)G * NTHR) { const size_t r = i / ncols, c = i % ncols; out[r * 1024 + coloff + c] = bflo((unsigned)src[r * pitch + c]); }
}
#define DBG(n, stmt) do { if (DBG_STAGE == (n) && l == 0) { GSYNC(); stmt; return; } } while (0)
template <class Epi> __device__ __forceinline__ void run_gemm(LAS unsigned char* lds, const bf16* A, const bf16* Bt, int M, int N, int K, int bshift, int G, const Epi& E) {
    pg8::Gemm g{A, Bt, M, N, K, bshift}; pg8::StaticOrder S; S.init(M, N, G, (int)blockIdx.x);
    pg8::gemm_phase<Epi, pg8::StaticOrder, true, true>(lds, g, S, E);
}

__global__ void __launch_bounds__(NTHR, 2) fwd_megakernel(Args args) {
    extern __shared__ __attribute__((aligned(16))) unsigned char lds_raw[];
    LAS unsigned char* lds = (LAS unsigned char*)lds_raw;
    cg::grid_group grid = cg::this_grid();
    const int tid = threadIdx.x, lane = tid & 63, wave = __builtin_amdgcn_readfirstlane(tid >> 6), G = gridDim.x;
    const int gw = blockIdx.x * NWAVES + wave, NGW = G * NWAVES;
    volatile LAS unsigned* bst = (volatile LAS unsigned*)(lds + 131072 + 1024);
    if (tid == 0) { bst[0] = 0u; bst[1] = 0u; }
    __syncthreads();
    (void)xcd_barrier_post((unsigned*)(args.ws + WS_BAR), bst);
    grid.sync();
#define GSYNC() do { XcdBarrier b_; b_.bar = (unsigned*)(args.ws + WS_BAR); b_.x = xb_xcc_id(); b_.st = (volatile LAS unsigned*)(lds + 131072 + 1024); xcd_barrier(b_); } while (0)
#define OPQ(p) asm volatile("" : "+s"(p))
#define WSP(name) unsigned char* name = args.ws; OPQ(name)
    {   WSP(ws);
        p0_prologue(args, lds, tid, lane, wave, G);
#ifdef PROBE_P02
        __syncthreads(); p0_prologue(args, lds, tid, lane, wave, G);
#endif
#ifdef DIAG_FILL
        { v4u* z = (v4u*)(ws + WS_H); const size_t n16 = (WS_END - WS_H) / 16; const v4u zero = {0u, 0u, 0u, 0u};
          for (size_t i = (size_t)blockIdx.x * NTHR + tid; i < n16; i += (size_t)G * NTHR) z[i] = zero; }
#endif
        GSYNC();
        float* MOD = (float*)(ws + WS_MOD);
        ln_pass<0>(args.in[0], nullptr, (bf16*)(ws + WS_H), nullptr, nullptr, MOD + 1 * DM, MOD + 0 * DM, gw, NGW, lane);
        GSYNC();
        { const int l = 0; if (DBG_STAGE == 1) { dbg_dump(args.out, (const bf16*)(ws + WS_H), 1024, 1024, 0, tid, G); return; } } }
#pragma unroll 1
    for (int l = 0; l < DEPTH; ++l) {
#ifndef DBG_SKIP_ATT
#ifdef PROBE_DOUBLE_PAPB
#pragma unroll 1
        for (int rep = 0; rep < 2; ++rep) {
#endif
        {   WSP(ws); const unsigned char* wl = ws + WS_W + (size_t)l * LW;
            EpiQKP E{(bf16*)(ws + WS_R2), (bf16*)(ws + WS_PIN)}; run_gemm(lds, (const bf16*)(ws + WS_H), (const bf16*)(wl + OW_QK), T, NQKP, DM, 0, G, E); }
#ifdef PROBE_VT2
#pragma unroll 1
        for (int rep = 0; rep < 2; ++rep)
#endif
#pragma unroll 1
        for (int g = 0; g < 3; ++g) { WSP(ws); const unsigned char* wl = ws + WS_W + (size_t)l * LW;
            EpiVT E{(bf16*)(ws + WS_R3) + (size_t)g * 512 * T, 2 * g}; run_gemm(lds, (const bf16*)(wl + OW_V) + (size_t)g * 512 * DM, (const bf16*)(ws + WS_H), 512, T, DM, 2 * g, G, E); }
        DBG(2, dbg_dump(args.out, (const bf16*)(args.ws + WS_R2) + (size_t)T * 1024, 1024, 1024, 0, tid, G));
        DBG(3, dbg_dump(args.out, (const bf16*)(args.ws + WS_R3), 1024, 1024, 0, tid, G));
        GSYNC();
        {   WSP(ws); attn_phase(lds, (bf16*)(ws + WS_R2), (const bf16*)(ws + WS_R3), (float*)(ws + WS_LSE), G, tid, wave); }
        DBG(4, dbg_dump(args.out, (const bf16*)(args.ws + WS_R2) + (size_t)2 * T * 1024, 1024, 1024, 0, tid, G));
        GSYNC();
#ifdef PROBE_DOUBLE_PAPB
        }
#endif
#ifdef PROBE_SYNC10
        for (int rep = 0; rep < 10; ++rep) GSYNC();
#endif
#ifdef PROBE_CP2
#pragma unroll 1
        for (int rep = 0; rep < 2; ++rep)
#endif
        {   WSP(ws); combine_pool_phase((const bf16*)(ws + WS_R2), (const float*)(ws + WS_LSE), (const bf16*)(ws + WS_PIN), (bf16*)(ws + WS_R3), (bf16*)(ws + WS_R3 + 32 * MiB), gw, NGW, lane); }
        DBG(5, { dbg_dump(args.out, (const bf16*)(args.ws + WS_R3), 512, 512, 0, tid, G); dbg_dump(args.out, (const bf16*)(args.ws + WS_R3 + 32 * MiB), 512, 512, 512, tid, G); });
        GSYNC();
#endif
        {   WSP(ws); const unsigned char* wl = ws + WS_W + (size_t)l * LW;
            EpiSig E{(bf16*)(ws + WS_R2)}; run_gemm(lds, (const bf16*)(ws + WS_H), (const bf16*)(wl + OW_G), T, 2048, DM, 0, G, E); }
        DBG(11, dbg_dump(args.out, (const bf16*)(args.ws + WS_R2) + 1024, 2048, 1024, 0, tid, G));
        GSYNC();
        {   WSP(ws); const unsigned char* wl = ws + WS_W + (size_t)l * LW;
            EpiMerge<false> E{(const bf16*)(ws + WS_R2), (bf16*)(ws + WS_R2 + 128 * MiB), 0}; run_gemm(lds, (const bf16*)(ws + WS_R3), (const bf16*)(wl + OW_ATT), T, DM, 512, 0, G, E); }
        {   WSP(ws); const unsigned char* wl = ws + WS_W + (size_t)l * LW;
            EpiMerge<true> E{(const bf16*)(ws + WS_R2), (bf16*)(ws + WS_R2 + 128 * MiB), 1024}; run_gemm(lds, (const bf16*)(ws + WS_R3 + 32 * MiB), (const bf16*)(wl + OW_PC), T, DM, 512, 0, G, E); }
        DBG(6, dbg_dump(args.out, (const bf16*)(args.ws + WS_R2 + 128 * MiB), 1024, 1024, 0, tid, G));
        GSYNC();
        {   WSP(ws); const unsigned char* wl = ws + WS_W + (size_t)l * LW; const float* modl = (const float*)(ws + WS_MOD) + (size_t)l * BATCH * NMOD;
            const float* xin = (l == 0) ? args.in[0] : args.out;
            EpiRes E{xin, args.out, modl + 2 * DM}; run_gemm(lds, (const bf16*)(ws + WS_R2 + 128 * MiB), (const bf16*)(wl + OW_O), T, DM, DM, 0, G, E); }
        DBG(7, (void)0);
        GSYNC();
        {   WSP(ws); const float* modl = (const float*)(ws + WS_MOD) + (size_t)l * BATCH * NMOD;
            ln_pass<1>(args.out, args.out, (bf16*)(ws + WS_H), args.in[10] + (size_t)l * DM, args.in[11] + (size_t)l * DM, modl + 4 * DM, modl + 3 * DM, gw, NGW, lane); }
        DBG(8, (void)0);
        GSYNC();
#ifdef PROBE_FFI2
#pragma unroll 1
        for (int rep = 0; rep < 2; ++rep)
#endif
        {   WSP(ws); const unsigned char* wl = ws + WS_W + (size_t)l * LW;
            EpiSwiGLU E{(bf16*)(ws + WS_R2)}; run_gemm(lds, (const bf16*)(ws + WS_H), (const bf16*)(wl + OW_FI), T, 2 * DFF, DM, 0, G, E); }
        DBG(9, dbg_dump(args.out, (const bf16*)(args.ws + WS_R2), DFF, 1024, 0, tid, G));
        GSYNC();
        {   WSP(ws); const unsigned char* wl = ws + WS_W + (size_t)l * LW; const float* modl = (const float*)(ws + WS_MOD) + (size_t)l * BATCH * NMOD;
            EpiRes E{args.out, args.out, modl + 5 * DM}; run_gemm(lds, (const bf16*)(ws + WS_R2), (const bf16*)(wl + OW_FO), T, DM, DFF, 0, G, E); }
        DBG(10, (void)0);
        GSYNC();
        {   WSP(ws); const float* modl = (const float*)(ws + WS_MOD) + (size_t)l * BATCH * NMOD;
            if (l + 1 < DEPTH) ln_pass<1>(args.out, args.out, (bf16*)(ws + WS_H), args.in[14] + (size_t)l * DM, args.in[15] + (size_t)l * DM, modl + BATCH * NMOD + 1 * DM, modl + BATCH * NMOD + 0 * DM, gw, NGW, lane);
            else ln_pass<2>(args.out, args.out, nullptr, args.in[14] + (size_t)l * DM, args.in[15] + (size_t)l * DM, nullptr, nullptr, gw, NGW, lane); }
        if (l + 1 < DEPTH) GSYNC();
    }
}

extern "C" void kernel_launch(void* const* d_in, const int* in_sizes, int n_in, void* d_out, int out_size, void* d_ws, size_t ws_size, hipStream_t stream) {
    static int grid = 0;
    if (grid == 0) {
        if (n_in != 16 || out_size != T * DM || ws_size < WS_END) { fprintf(stderr, "kernel_launch: unexpected shapes (n_in %d, out %d, ws %zu < %zu)\n", n_in, out_size, ws_size, (size_t)WS_END); grid = -1; return; }
        int dev = 0, cus = 0, per_cu = 0;
        (void)hipGetDevice(&dev); (void)hipDeviceGetAttribute(&cus, hipDeviceAttributeMultiprocessorCount, dev);
        if (hipFuncSetAttribute((const void*)fwd_megakernel, hipFuncAttributeMaxDynamicSharedMemorySize, LDS_BYTES) != hipSuccess) { fprintf(stderr, "kernel_launch: hipFuncSetAttribute failed\n"); grid = -1; return; }
        if (hipOccupancyMaxActiveBlocksPerMultiprocessor(&per_cu, (const void*)fwd_megakernel, NTHR, LDS_BYTES) != hipSuccess || per_cu < 1) { fprintf(stderr, "kernel_launch: occupancy query says %d\n", per_cu); per_cu = 1; }
        (void)hipGetLastError();
        grid = cus * 1;
    }
    if (grid < 0) return;
    Args a{};
    for (int i = 0; i < 16; ++i) a.in[i] = (const float*)d_in[i];
    a.out = (float*)d_out; a.ws = (unsigned char*)d_ws;
    if (hipMemsetAsync((char*)d_ws + WS_BAR, 0, 16384, stream) != hipSuccess) { fprintf(stderr, "kernel_launch: hipMemsetAsync failed\n"); return; }
    void* kargs[] = {&a};
    hipError_t e = hipLaunchCooperativeKernel((const void*)fwd_megakernel, dim3(grid), dim3(NTHR), kargs, LDS_BYTES, stream);
    if (e != hipSuccess) fprintf(stderr, "kernel_launch: cooperative launch failed: %s (grid %d)\n", hipGetErrorString(e), grid);
}
```
